# Optimizing an MI355X kernel written in HIP

```python
import math
import jax
import jax.numpy as jnp
from jax import lax
import numpy as np


D_MODEL = 1024
BATCH = 8
SEQ = 4096
DEPTH = 4

HEAD_DIM = 64
N_HEADS_GDN = 6
N_HEADS_DSW = 6
N_HEADS_SB = 4
D_GDN = N_HEADS_GDN * HEAD_DIM
D_DSW = N_HEADS_DSW * HEAD_DIM
D_SB = N_HEADS_SB * HEAD_DIM
D_MIX = D_GDN + D_DSW + D_SB
CONV_WIDTH = 4
GDN_CHUNK = 64
DSW_CONFIGS = ((128, 1), (512, 4), (2048, 16))
SB_BLOCK = 128
D_FF = 2816
N_EXPERTS = 8
TOP_K = 2
MOE_D_FF = 3584
PLE_DIM = 256
N_DENSE = (DEPTH + 1) // 2
N_MOE = DEPTH // 2
RMS_EPS = 1e-6
IN_SPLITS = (D_GDN,) * 4 + (N_HEADS_GDN,) * 2 + (D_DSW,) * 3 + (D_SB,) * 3
D_IN = 4 * D_GDN + 2 * N_HEADS_GDN + 3 * D_DSW + 3 * D_SB

kernel_name = 'hybrid_gdn_dilated_stickbreaking_moe'

F32 = jnp.float32


def rms_norm(x, w):
    xf = x.astype(F32)
    y = xf * lax.rsqrt(jnp.mean(xf * xf, axis=-1, keepdims=True) + RMS_EPS)
    return (y * w.astype(F32)).astype(x.dtype)


def l2_normalize(x):
    xf = x.astype(F32)
    return xf * lax.rsqrt(jnp.sum(xf * xf, axis=-1, keepdims=True) + RMS_EPS)


def to_heads(t, n_heads):
    b, s, _ = t.shape
    return t.reshape(b, s, n_heads, -1).transpose(0, 2, 1, 3)


def from_heads(t):
    b, h, s, d = t.shape
    return t.transpose(0, 2, 1, 3).reshape(b, s, h * d)


def causal_depthwise_conv(x, w):
    c = x.shape[-1]
    y = lax.conv_general_dilated(
        x, w.astype(x.dtype)[:, None, :], window_strides=(1,),
        padding=[(CONV_WIDTH - 1, 0)], dimension_numbers=('NWC', 'WIO', 'NWC'),
        feature_group_count=c)
    return jax.nn.silu(y)


def gated_delta_rule(q, k, v, g, beta):
    b, h, s, dk = q.shape
    dv = v.shape[-1]
    c = GDN_CHUNK
    n = s // c

    def chunks(t):
        t = t.astype(F32).reshape(b, h, n, c, *t.shape[3:])
        return jnp.moveaxis(t, 2, 0)

    q = chunks(q) * (dk ** -0.5)
    k, v, g, beta = chunks(k), chunks(v), chunks(g), chunks(beta)
    G = jnp.cumsum(g, axis=-1)
    idx = jnp.arange(c)
    causal = idx[:, None] >= idx[None, :]
    strict = idx[:, None] > idx[None, :]
    decay = jnp.exp(jnp.where(causal, G[..., :, None] - G[..., None, :], -jnp.inf))
    kk = jnp.einsum('nbhid,nbhjd->nbhij', k, k)
    tri = jnp.where(strict, beta[..., :, None] * kk * decay, 0.0) + jnp.eye(c, dtype=F32)
    rhs = jnp.concatenate([v * beta[..., None], k * (beta * jnp.exp(G))[..., None]], axis=-1)
    sol = lax.linalg.triangular_solve(tri, rhs, left_side=True, lower=True, unit_diagonal=True)
    u, w = sol[..., :dv], sol[..., dv:]
    qk = jnp.einsum('nbhid,nbhjd->nbhij', q, k) * decay
    q_dec = q * jnp.exp(G)[..., None]
    k_dec = k * jnp.exp(G[..., -1:] - G)[..., None]
    g_tot = jnp.exp(G[..., -1])[..., None, None]

    def step(state, xs):
        u_n, w_n, qk_n, q_n, k_n, gt_n = xs
        v_new = u_n - jnp.einsum('bhcd,bhde->bhce', w_n, state)
        o_n = jnp.einsum('bhcd,bhde->bhce', q_n, state) + jnp.einsum('bhij,bhje->bhie', qk_n, v_new)
        state = state * gt_n + jnp.einsum('bhcd,bhce->bhde', k_n, v_new)
        return state, o_n

    s0 = jnp.zeros((b, h, dk, dv), F32)
    _, o = lax.scan(step, s0, (u, w, qk, q_dec, k_dec, g_tot))
    return jnp.moveaxis(o, 0, 2).reshape(b, h, s, dv)


def gdn_mixer(q, k, v, z, a, bl, conv_w, a_log, dt_bias, norm_w):
    qkv = causal_depthwise_conv(jnp.concatenate([q, k, v], axis=-1), conv_w)
    q, k, v = jnp.split(qkv, 3, axis=-1)
    q = l2_normalize(to_heads(q, N_HEADS_GDN))
    k = l2_normalize(to_heads(k, N_HEADS_GDN))
    v = to_heads(v, N_HEADS_GDN)
    g = -jnp.exp(a_log.astype(F32)) * jax.nn.softplus(a.astype(F32) + dt_bias.astype(F32))
    beta = jax.nn.sigmoid(bl.astype(F32))
    o = gated_delta_rule(q, k, v, g.transpose(0, 2, 1), beta.transpose(0, 2, 1))
    o = from_heads(rms_norm(o, norm_w))
    return (o * jax.nn.silu(z.astype(F32))).astype(z.dtype)


def alibi_slopes(n):
    return 2.0 ** (-8.0 * (jnp.arange(n, dtype=F32) + 1.0) / n)


def dilated_window_attention(q, k, v, slopes, window, dilation):
    b, h, s, d = q.shape
    r = dilation
    span = window // dilation
    blk = span
    L = s // r
    nb = -(-L // blk)
    lp = nb * blk

    def sub(t):
        t = t.reshape(b, h, L, r, d).transpose(0, 1, 3, 2, 4)
        t = jnp.pad(t, ((0, 0), (0, 0), (0, 0), (0, lp - L), (0, 0)))
        return t.reshape(b, h, r, nb, blk, d)

    def with_prev(t):
        prev = jnp.pad(t[:, :, :, :-1], ((0, 0), (0, 0), (0, 0), (1, 0), (0, 0), (0, 0)))
        return jnp.concatenate([prev, t], axis=4)

    qb = sub(q)
    kc, vc = with_prev(sub(k)), with_prev(sub(v))
    scores = jnp.einsum('bhrnqd,bhrnkd->bhrnqk', qb, kc).astype(F32) * (d ** -0.5)
    qi = jnp.arange(blk)[:, None]
    ki = jnp.arange(2 * blk)[None, :]
    dist = qi - ki + blk
    n_idx = jnp.arange(nb)[:, None, None]
    valid = (dist >= 0) & (dist <= span) & (n_idx * blk + ki - blk >= 0)
    bias = -slopes[:, None, None, None, None] * (dist * r).astype(F32)
    scores = jnp.where(valid, scores + bias, -jnp.inf)
    m = jnp.max(scores, axis=-1, keepdims=True)
    e = jnp.exp(scores - m)
    den = jnp.sum(e, axis=-1, keepdims=True)
    o = jnp.einsum('bhrnqk,bhrnkd->bhrnqd', e, vc.astype(F32)) / den
    lse = (m + jnp.log(den))[..., 0]

    def unsub(t):
        t = t.reshape(b, h, r, lp, *t.shape[5:])[:, :, :, :L]
        t = jnp.moveaxis(t, 2, 3)
        return t.reshape(b, h, s, *t.shape[4:])

    return unsub(o), unsub(lse)


def dsw_mixer(q, k, v):
    slopes = alibi_slopes(N_HEADS_DSW)
    outs = []
    lses = []
    for window, dilation in DSW_CONFIGS:
        o_c, lse_c = dilated_window_attention(q, k, v, slopes, window, dilation)
        outs.append(o_c)
        lses.append(lse_c)
    wts = jax.nn.softmax(jnp.stack(lses, axis=0), axis=0)
    return jnp.sum(wts[..., None] * jnp.stack(outs, axis=0), axis=0)


def stick_breaking_attention(q, k, v):
    b, h, s, d = q.shape
    nb = s // SB_BLOCK
    kf = k.astype(F32)
    vf = v.astype(F32)
    qb = jnp.moveaxis(q.astype(F32).reshape(b, h, nb, SB_BLOCK, d), 2, 0) * (d ** -0.5)
    key_pos = jnp.arange(s)

    def block(args):
        q_blk, start = args
        z = jnp.einsum('bhqd,bhkd->bhqk', q_blk, kf)
        t = start + jnp.arange(SB_BLOCK)
        before = key_pos[None, :] < t[:, None]
        log_keep = jnp.where(before, jax.nn.log_sigmoid(-z), 0.0)
        suffix = lax.cumsum(log_keep, axis=3, reverse=True) - log_keep
        a = jnp.where(before, jnp.exp(jax.nn.log_sigmoid(z) + suffix), 0.0)
        return jnp.einsum('bhqk,bhkd->bhqd', a, vf)

    o = lax.map(block, (qb, jnp.arange(nb) * SB_BLOCK))
    return jnp.moveaxis(o, 0, 2).reshape(b, h, s, d)


def token_mixers(hn, w_in, conv_w, a_log, dt_bias, gdn_norm_w, dsw_norm_w, sb_norm_w, w_out):
    proj = hn @ w_in
    cuts = [int(c) for c in np.cumsum(IN_SPLITS)[:-1]]
    (gq, gk, gv, gz, ga, gb, dq, dk, dv, sq, sk, sv) = jnp.split(proj, cuts, axis=-1)
    o_gdn = gdn_mixer(gq, gk, gv, gz, ga, gb, conv_w, a_log, dt_bias, gdn_norm_w)
    o_dsw = dsw_mixer(to_heads(dq, N_HEADS_DSW), to_heads(dk, N_HEADS_DSW), to_heads(dv, N_HEADS_DSW))
    o_dsw = from_heads(rms_norm(o_dsw, dsw_norm_w))
    o_sb = stick_breaking_attention(to_heads(sq, N_HEADS_SB), to_heads(sk, N_HEADS_SB), to_heads(sv, N_HEADS_SB))
    o_sb = from_heads(rms_norm(o_sb, sb_norm_w))
    o = jnp.concatenate([o_gdn.astype(hn.dtype), o_dsw.astype(hn.dtype), o_sb.astype(hn.dtype)], axis=-1)
    return o @ w_out


def swiglu(x, w1, w3, w2):
    return (jax.nn.silu(x @ w1) * (x @ w3)) @ w2


def moe_swiglu(x, router_w, w1, w3, w2):
    logits = (x @ router_w).astype(F32)
    top_val, top_idx = lax.top_k(logits, TOP_K)
    top_w = jax.nn.softmax(top_val, axis=-1)
    gates = jnp.sum(jax.nn.one_hot(top_idx, N_EXPERTS, dtype=F32) * top_w[..., None], axis=-2)
    y = jnp.zeros(x.shape, F32)
    for e in range(N_EXPERTS):
        y = y + gates[..., e:e + 1] * swiglu(x, w1[e], w3[e], w2[e]).astype(F32)
    return y.astype(x.dtype)


def setup_inputs(seed: int = 0) -> dict:
    key = jax.random.key(seed)
    ks = jax.random.split(key, 24)

    def nrm(k, shape, scale):
        return scale * jax.random.normal(k, shape, F32)

    dt = jnp.exp(jax.random.uniform(ks[6], (DEPTH, N_HEADS_GDN), F32, math.log(1e-3), math.log(1e-1)))
    return {
        'x': nrm(ks[0], (BATCH, SEQ, D_MODEL), 1.0),
        'p': nrm(ks[1], (DEPTH, BATCH, SEQ, PLE_DIM), 1.0),
        'attn_norm_w': 1.0 + nrm(ks[2], (DEPTH, D_MODEL), 0.02),
        'w_in': nrm(ks[3], (DEPTH, D_MODEL, D_IN), D_MODEL ** -0.5),
        'conv_w': nrm(ks[4], (DEPTH, CONV_WIDTH, 3 * D_GDN), CONV_WIDTH ** -0.5),
        'a_log': jnp.log(jax.random.uniform(ks[5], (DEPTH, N_HEADS_GDN), F32, 1.0, 16.0)),
        'dt_bias': dt + jnp.log(-jnp.expm1(-dt)),
        'gdn_norm_w': 1.0 + nrm(ks[7], (DEPTH, HEAD_DIM), 0.02),
        'dsw_norm_w': 1.0 + nrm(ks[8], (DEPTH, HEAD_DIM), 0.02),
        'sb_norm_w': 1.0 + nrm(ks[9], (DEPTH, HEAD_DIM), 0.02),
        'w_out': nrm(ks[10], (DEPTH, D_MIX, D_MODEL), D_MIX ** -0.5),
        'ffn_norm_w': 1.0 + nrm(ks[11], (DEPTH, D_MODEL), 0.02),
        'ffn_w1': nrm(ks[12], (N_DENSE, D_MODEL, D_FF), D_MODEL ** -0.5),
        'ffn_w3': nrm(ks[13], (N_DENSE, D_MODEL, D_FF), D_MODEL ** -0.5),
        'ffn_w2': nrm(ks[14], (N_DENSE, D_FF, D_MODEL), D_FF ** -0.5),
        'router_w': nrm(ks[15], (N_MOE, D_MODEL, N_EXPERTS), D_MODEL ** -0.5),
        'moe_w1': nrm(ks[16], (N_MOE, N_EXPERTS, D_MODEL, MOE_D_FF), D_MODEL ** -0.5),
        'moe_w3': nrm(ks[17], (N_MOE, N_EXPERTS, D_MODEL, MOE_D_FF), D_MODEL ** -0.5),
        'moe_w2': nrm(ks[18], (N_MOE, N_EXPERTS, MOE_D_FF, D_MODEL), MOE_D_FF ** -0.5),
        'ple_proj': nrm(ks[19], (DEPTH, PLE_DIM, D_MODEL), PLE_DIM ** -0.5),
        'ple_norm_w': 1.0 + nrm(ks[20], (DEPTH, D_MODEL), 0.02),
        'ple_gate': nrm(ks[21], (DEPTH, D_MODEL, D_MODEL), D_MODEL ** -0.5),
        'final_norm_w': 1.0 + nrm(ks[22], (D_MODEL,), 0.02),
    }


def reference(x, p, attn_norm_w, w_in, conv_w, a_log, dt_bias, gdn_norm_w, dsw_norm_w,
              sb_norm_w, w_out, ffn_norm_w, ffn_w1, ffn_w3, ffn_w2, router_w, moe_w1,
              moe_w3, moe_w2, ple_proj, ple_norm_w, ple_gate, final_norm_w):
    h = x
    for i in range(DEPTH):
        hn = rms_norm(h, attn_norm_w[i])
        h = h + token_mixers(hn, w_in[i], conv_w[i], a_log[i], dt_bias[i], gdn_norm_w[i],
                             dsw_norm_w[i], sb_norm_w[i], w_out[i])
        hn = rms_norm(h, ffn_norm_w[i])
        j = i // 2
        if i % 2 == 0:
            h = h + swiglu(hn, ffn_w1[j], ffn_w3[j], ffn_w2[j])
        else:
            h = h + moe_swiglu(hn, router_w[j], moe_w1[j], moe_w3[j], moe_w2[j])
        gate = jax.nn.sigmoid(rms_norm(h, ple_norm_w[i]) @ ple_gate[i])
        h = h + (p[i] @ ple_proj[i]) * gate
    return rms_norm(h, final_norm_w)
```

```cpp
#include <hip/hip_runtime.h>
#include <cstdio>
#include <cstdint>
__device__ __forceinline__ int mk_lane() { int l; asm volatile("v_mbcnt_lo_u32_b32 %0, -1, 0\n\tv_mbcnt_hi_u32_b32 %0, -1, %0" : "=v"(l)); return l; }
namespace pg8 {
#define PG8_LAS __attribute__((address_space(3)))
typedef unsigned short bf16_t;
typedef short bf16x8 __attribute__((ext_vector_type(8)));
typedef float f32x4 __attribute__((ext_vector_type(4)));
typedef unsigned u32x4 __attribute__((ext_vector_type(4)));
constexpr int BM = 256, BK = 64, HALF = 128, HTB = HALF * BK * 2  , STAGE_BYTES = 8 * HTB, NXCD = 8, WGM = 8;

__host__ __device__ __forceinline__ int lds_byte(int r, int c) { const int st = (r >> 4) * 2 + (c >> 5), rr = r & 15, cc = c & 31, ob = rr * 64 + cc * 2; return st * 1024 + (ob ^ (((ob >> 9) & 1) << 5)); }
__host__ __device__ __forceinline__ void stage_rc(int b, int& R, int& C) { const int st = b / 1024, sb = b % 1024, swz = sb ^ (((sb >> 9) & 1) << 5); R = (st >> 1) * 16 + swz / 64; C = (st & 1) * 32 + (swz % 64) / 2; }
__host__ __device__ __forceinline__ int perm32(int rho) { const int n = rho >> 4, i = rho & 15; return 8 * (i >> 2) + 4 * n + (i & 3); }

struct Unit { int pm, pn; };
struct Gemm { const bf16_t* A; const bf16_t* Bt; int M, N, K; };

struct StaticOrder {
    int nM, nN, nwg, G, c;
    __host__ __device__ void init(int M, int N, int G_, int c_) { nM = M / BM; nN = N / BM; nwg = nM * nN; G = G_; c = c_; }
    __host__ __device__ bool next(int i, Unit& u) const {
        const long L = (long)i * G + c; if (L >= nwg) return false;
        int wgid = (int)L; { const int q = nwg / NXCD, r = nwg % NXCD, xcd = wgid % NXCD, off = wgid / NXCD; wgid = (xcd < r ? xcd * (q + 1) : r * (q + 1) + (xcd - r) * q) + off; }
        const int nig = WGM * nN, gid = wgid / nig, fm = gid * WGM, gsz = (nM - fm) < WGM ? (nM - fm) : WGM;
        u.pm = fm + ((wgid % nig) % gsz); u.pn = (wgid % nig) / gsz; return true;
    }
    __device__ __forceinline__ void a_ready(const Unit&) const {}
    __device__ __forceinline__ void done(const Unit&) const {}
};

__device__ __forceinline__ unsigned cvt_pk_bf16(float lo, float hi) { unsigned r; asm volatile("v_cvt_pk_bf16_f32 %0, %1, %2" : "=v"(r) : "v"(lo), "v"(hi)); return r; }
typedef float f32x2 __attribute__((ext_vector_type(2)));
typedef unsigned u32x2 __attribute__((ext_vector_type(2)));
__device__ __forceinline__ float bf_lo(unsigned u) { return __uint_as_float(u << 16); }
__device__ __forceinline__ float bf_hi(unsigned u) { return __uint_as_float(u & 0xffff0000u); }
__device__ __forceinline__ float sigmoidf_(float x) { return __builtin_amdgcn_rcpf(1.0f + __expf(-x)); }
struct EpiStore {
    static constexpr bool PERM = true, AFTER_DRAIN = false;
    bf16_t* O; int ldc; int nN;
    __device__ __forceinline__ void operator()(const f32x4 (&acc)[2][2][4][2], const Unit& u, int wr_, int wc_, int fr_, int fq_) const {
        (void)fr_; (void)fq_; const int ln_ = mk_lane(), fr = ln_ & 15, fq = ln_ >> 4, wr = wr_, wc = wc_;
        const int row0 = u.pm * BM + wr * 64 + fr; const int col0 = (u.pn % nN) * BM + wc * 32 + 8 * fq;
#pragma unroll
        for (int ai = 0; ai < 2; ++ai)
#pragma unroll
            for (int m = 0; m < 4; ++m) { bf16_t* rowp = O + (size_t)(row0 + ai * HALF + m * 16) * ldc + col0;
#pragma unroll
                for (int bj = 0; bj < 2; ++bj) { const f32x4 v0 = acc[ai][bj][m][0], v1 = acc[ai][bj][m][1];
                    u32x4 w; w.x = cvt_pk_bf16(v0[0], v0[1]); w.y = cvt_pk_bf16(v0[2], v0[3]); w.z = cvt_pk_bf16(v1[0], v1[1]); w.w = cvt_pk_bf16(v1[2], v1[3]);
                    *(u32x4*)(rowp + bj * HALF) = w; } }
    }
};
struct EpiSwiGLU {
    static constexpr bool PERM = true, AFTER_DRAIN = false;
    bf16_t* O; int ldc; int nN;
    __device__ __forceinline__ void operator()(const f32x4 (&acc)[2][2][4][2], const Unit& u, int wr_, int wc_, int fr_, int fq_) const {
        (void)fr_; (void)fq_; const int ln_ = mk_lane(), fr = ln_ & 15, fq = ln_ >> 4, wr = wr_, wc = wc_;
        const int row0 = u.pm * BM + wr * 64 + fr; const int col0 = (u.pn % nN) * HALF + wc * 32 + 8 * fq;
#pragma unroll
        for (int ai = 0; ai < 2; ++ai)
#pragma unroll
            for (int m = 0; m < 4; ++m) { bf16_t* rowp = O + (size_t)(row0 + ai * HALF + m * 16) * ldc + col0;
                float r[8];
#pragma unroll
                for (int n = 0; n < 2; ++n)
#pragma unroll
                    for (int i = 0; i < 4; ++i) { const float a = acc[ai][0][m][n][i], b = acc[ai][1][m][n][i]; r[n * 4 + i] = a * sigmoidf_(a) * b; }
                u32x4 w; w.x = cvt_pk_bf16(r[0], r[1]); w.y = cvt_pk_bf16(r[2], r[3]); w.z = cvt_pk_bf16(r[4], r[5]); w.w = cvt_pk_bf16(r[6], r[7]);
                *(u32x4*)rowp = w; }
    }
};
struct EpiResid {
    static constexpr bool PERM = false, AFTER_DRAIN = false;
    const float* base; float* out; int ldc;
    __device__ __forceinline__ void operator()(const f32x4 (&acc)[2][2][4][2], const Unit& u, int wr_, int wc_, int fr_, int fq_) const {
        (void)fr_; (void)fq_; const int ln_ = mk_lane(), fr = ln_ & 15, fq = ln_ >> 4, wr = wr_, wc = wc_;
        const int col0 = u.pn * BM + wc * 32 + 4 * fq;
#pragma unroll
        for (int ai = 0; ai < 2; ++ai)
#pragma unroll
            for (int m = 0; m < 4; ++m) { const size_t off = (size_t)(u.pm * BM + ai * HALF + wr * 64 + m * 16 + fr) * ldc + col0;
#pragma unroll
                for (int bj = 0; bj < 2; ++bj)
#pragma unroll
                    for (int n = 0; n < 2; ++n) { const size_t p = off + bj * HALF + n * 16; const f32x4 bs = *(const f32x4*)(base + p); *(f32x4*)(out + p) = bs + acc[ai][bj][m][n]; } }
    }
};
struct EpiPleP {
    static constexpr bool PERM = false, AFTER_DRAIN = false;
    bf16_t* P; int ldc;
    __device__ __forceinline__ void operator()(const f32x4 (&acc)[2][2][4][2], const Unit& u, int wr_, int wc_, int fr_, int fq_) const {
        (void)fr_; (void)fq_; const int ln_ = mk_lane(), fr = ln_ & 15, fq = ln_ >> 4, wr = wr_, wc = wc_;
        const int col0 = u.pn * BM + wc * 32 + 4 * fq;
#pragma unroll
        for (int ai = 0; ai < 2; ++ai)
#pragma unroll
            for (int m = 0; m < 4; ++m) { const size_t off = (size_t)(u.pm * BM + ai * HALF + wr * 64 + m * 16 + fr) * ldc + col0;
#pragma unroll
                for (int bj = 0; bj < 2; ++bj)
#pragma unroll
                    for (int n = 0; n < 2; ++n) { const f32x4 v = acc[ai][bj][m][n]; u32x2 w; w.x = cvt_pk_bf16(v[0], v[1]); w.y = cvt_pk_bf16(v[2], v[3]); *(u32x2*)(P + off + bj * HALF + n * 16) = w; } }
    }
};
struct EpiPleG {
    static constexpr bool PERM = false, AFTER_DRAIN = false;
    const float* base; float* out; const bf16_t* P; int ldc;
    __device__ __forceinline__ void operator()(const f32x4 (&acc)[2][2][4][2], const Unit& u, int wr_, int wc_, int fr_, int fq_) const {
        (void)fr_; (void)fq_; const int ln_ = mk_lane(), fr = ln_ & 15, fq = ln_ >> 4, wr = wr_, wc = wc_;
        const int col0 = u.pn * BM + wc * 32 + 4 * fq;
#pragma unroll
        for (int ai = 0; ai < 2; ++ai)
#pragma unroll
            for (int m = 0; m < 4; ++m) { const size_t off = (size_t)(u.pm * BM + ai * HALF + wr * 64 + m * 16 + fr) * ldc + col0;
#pragma unroll
                for (int bj = 0; bj < 2; ++bj)
#pragma unroll
                    for (int n = 0; n < 2; ++n) { const size_t p = off + bj * HALF + n * 16; const f32x4 bs = *(const f32x4*)(base + p); const u32x2 pw = *(const u32x2*)(P + p); const f32x4 a = acc[ai][bj][m][n];
                        f32x4 o; o[0] = bs[0] + bf_lo(pw.x) * sigmoidf_(a[0]); o[1] = bs[1] + bf_hi(pw.x) * sigmoidf_(a[1]); o[2] = bs[2] + bf_lo(pw.y) * sigmoidf_(a[2]); o[3] = bs[3] + bf_hi(pw.y) * sigmoidf_(a[3]);
                        *(f32x4*)(out + p) = o; } }
    }
};
struct GroupedOrder {
    StaticOrder so; int nN; const PG8_LAS int* tile_e;
    __device__ void init(int Mp, int N, int G_, int c_, const PG8_LAS int* te) { so.init(Mp, N, G_, c_); nN = N / BM; tile_e = te; }
    __device__ bool next(int i, Unit& u) const { if (!so.next(i, u)) return false; u.pn += tile_e[u.pm] * nN; return true; }
    __device__ __forceinline__ void a_ready(const Unit&) const {}
    __device__ __forceinline__ void done(const Unit&) const {}
};
template <class Epi, class Sched, bool ALIGN_EPI = false, bool SP2 = false>
__device__ __forceinline__ void gemm_phase(PG8_LAS unsigned char* lds, const Gemm g, const Sched& S, const Epi& E, int wave_s) {
    int tid_ = wave_s * 64 + mk_lane(); asm volatile("" : "+v"(tid_));
    const int tid = tid_, wid = __builtin_amdgcn_readfirstlane(tid >> 6), lane = tid & 63, wr = wid >> 2, wc = wid & 3, fr = lane & 15, fq = lane >> 4;
    const int K = g.K, nt = K / BK;
    unsigned voffA[2], voffB[2];
#pragma unroll
    for (int i = 0; i < 2; ++i) { int R, C; stage_rc(tid * 16 + i * 8192, R, C); const int Rb = Epi::PERM ? ((R & ~31) + perm32(R & 31)) : R;
        voffA[i] = (unsigned)(R * K + C) * 2u; voffB[i] = (unsigned)(Rb * K + C) * 2u; }
    const size_t kstep = (size_t)(BK * 2);
    const size_t hstep = (size_t)HALF * K * 2;
    const size_t tstep = 2 * hstep;
    const unsigned ldsw = (unsigned)wid * 1024u;
    const int aoff = lds_byte(wr * 64 + fr, fq * 8), boff = lds_byte(wc * 32 + fr, fq * 8);
#define PG8_SA(b, h) (((b) * 2 + (h)) * HTB)
#define PG8_SB(b, h) ((4 + (b) * 2 + (h)) * HTB)
#define PG8_STAGE(bufoff, gbase, voff) do { _Pragma("unroll") for (int _i = 0; _i < 2; ++_i) \
        __builtin_amdgcn_global_load_lds((const unsigned*)((const char*)(gbase) + (voff)[_i]), (PG8_LAS unsigned*)(lds + (bufoff) + ldsw + _i * 8192), 16, 0, 0); } while (0)
#define PG8_LDA(dst, b, h) do { _Pragma("unroll") for (int m = 0; m < 4; ++m) _Pragma("unroll") for (int k = 0; k < 2; ++k) dst[m][k] = *(const PG8_LAS bf16x8*)(lds + PG8_SA(b, h) + aoff + m * 2048 + k * 1024); } while (0)
#define PG8_LDB(dst, b, h) do { _Pragma("unroll") for (int n = 0; n < 2; ++n) _Pragma("unroll") for (int k = 0; k < 2; ++k) dst[n][k] = *(const PG8_LAS bf16x8*)(lds + PG8_SB(b, h) + boff + n * 2048 + k * 1024); } while (0)
#define PG8_MMA(ai, bj, At, Bt) do { __builtin_amdgcn_s_setprio(1); _Pragma("unroll") for (int m = 0; m < 4; ++m) _Pragma("unroll") for (int n = 0; n < 2; ++n) _Pragma("unroll") for (int k = 0; k < 2; ++k) \
        acc[ai][bj][m][n] = __builtin_amdgcn_mfma_f32_16x16x32_bf16(Bt[n][k], At[m][k], acc[ai][bj][m][n], 0, 0, 0); __builtin_amdgcn_s_setprio(0); } while (0)
#define PG8_WAIT_V(n) asm volatile("s_waitcnt vmcnt(" #n ")" ::: "memory")
#define PG8_WAIT_L(n) asm volatile("s_waitcnt lgkmcnt(" #n ")" ::: "memory")
#define PG8_BAR __builtin_amdgcn_s_barrier()
#define PG8_SCHED __builtin_amdgcn_sched_barrier(0)
    Unit cur, nxt; int ui = 0;
    if (!S.next(0, cur)) return;
    f32x4 acc[2][2][4][2];
    float zf_ = 0.f; asm volatile("" : "+v"(zf_));
#pragma unroll
    for (int a = 0; a < 2; ++a)
#pragma unroll
        for (int b = 0; b < 2; ++b)
#pragma unroll
            for (int m = 0; m < 4; ++m)
#pragma unroll
                for (int n = 0; n < 2; ++n) acc[a][b][m][n] = (f32x4){zf_, zf_, zf_, zf_};
    bf16x8 At[4][2], B0[2][2], B1[2][2];
    const char* cA = (const char*)g.A + (size_t)cur.pm * tstep; const char* cB = (const char*)g.Bt + (size_t)cur.pn * tstep;
    S.a_ready(cur);
    if constexpr (SP2) {
        PG8_STAGE(PG8_SB(0, 0), cB, voffB); PG8_STAGE(PG8_SB(0, 1), cB + hstep, voffB); PG8_STAGE(PG8_SA(0, 0), cA, voffA); PG8_STAGE(PG8_SA(0, 1), cA + hstep, voffA);
        if (wr == 1) PG8_BAR;
        PG8_WAIT_V(2); PG8_BAR;
        PG8_STAGE(PG8_SB(1, 0), cB + kstep, voffB); PG8_STAGE(PG8_SA(1, 0), cA + kstep, voffA); PG8_STAGE(PG8_SB(1, 1), cB + hstep + kstep, voffB);
        PG8_WAIT_V(6); PG8_BAR;
    } else {
        PG8_STAGE(PG8_SB(0, 0), cB, voffB); PG8_STAGE(PG8_SA(0, 0), cA, voffA); PG8_STAGE(PG8_SB(0, 1), cB + hstep, voffB); PG8_STAGE(PG8_SA(0, 1), cA + hstep, voffA);
        if (wr == 1) PG8_BAR;
        PG8_WAIT_V(4); PG8_BAR;
        PG8_STAGE(PG8_SB(1, 0), cB + kstep, voffB); PG8_STAGE(PG8_SA(1, 0), cA + kstep, voffA); PG8_STAGE(PG8_SB(1, 1), cB + hstep + kstep, voffB);
        PG8_WAIT_V(6); PG8_BAR;
    }
    for (;;) {
        const bool has_next = S.next(ui + 1, nxt);
        const char* nA = has_next ? (const char*)g.A + (size_t)nxt.pm * tstep : cA; const char* nB = has_next ? (const char*)g.Bt + (size_t)nxt.pn * tstep : cB;
        for (int t = 0; t < nt; t += 2) {
            const bool last = (t == nt - 2);
            const char* a1 = cA + (size_t)(t + 1) * kstep;
            const char* a2 = last ? nA : cA + (size_t)(t + 2) * kstep; const char* b2 = last ? nB : cB + (size_t)(t + 2) * kstep;
            const char* a3 = a2 + kstep; const char* b3 = b2 + kstep;
            if (last && has_next) S.a_ready(nxt);
            if constexpr (SP2) {
            PG8_LDB(B0, 0, 0); PG8_LDB(B1, 0, 1); PG8_SCHED; PG8_LDA(At, 0, 0); PG8_STAGE(PG8_SA(1, 1), a1 + hstep, voffA);
            PG8_WAIT_V(8); PG8_WAIT_L(0); PG8_BAR; PG8_MMA(0, 0, At, B0); PG8_MMA(0, 1, At, B1); PG8_BAR; PG8_SCHED;
            PG8_LDA(At, 0, 1); PG8_STAGE(PG8_SB(0, 0), b2, voffB); PG8_STAGE(PG8_SB(0, 1), b2 + hstep, voffB); PG8_STAGE(PG8_SA(0, 0), a2, voffA);
            PG8_WAIT_V(8); PG8_WAIT_L(0); PG8_BAR; PG8_MMA(1, 0, At, B0); PG8_MMA(1, 1, At, B1); PG8_BAR; PG8_SCHED;
            PG8_LDB(B0, 1, 0); PG8_LDB(B1, 1, 1); PG8_SCHED; PG8_LDA(At, 1, 0); PG8_STAGE(PG8_SA(0, 1), a2 + hstep, voffA);
            PG8_WAIT_V(8); PG8_WAIT_L(0); PG8_BAR; PG8_MMA(0, 0, At, B0); PG8_MMA(0, 1, At, B1); PG8_BAR; PG8_SCHED;
            PG8_LDA(At, 1, 1); PG8_STAGE(PG8_SB(1, 0), b3, voffB); PG8_STAGE(PG8_SB(1, 1), b3 + hstep, voffB); PG8_STAGE(PG8_SA(1, 0), a3, voffA);
            PG8_WAIT_V(8); PG8_WAIT_L(0); PG8_BAR; PG8_MMA(1, 0, At, B0); PG8_MMA(1, 1, At, B1); PG8_BAR; PG8_SCHED;
            } else {
            PG8_LDB(B0, 0, 0); PG8_SCHED; PG8_LDA(At, 0, 0); PG8_STAGE(PG8_SA(1, 1), a1 + hstep, voffA);
            PG8_WAIT_L(8); PG8_BAR; PG8_WAIT_L(0); PG8_MMA(0, 0, At, B0); PG8_BAR; PG8_SCHED;
            PG8_LDB(B1, 0, 1); PG8_STAGE(PG8_SB(0, 0), b2, voffB);
            PG8_BAR; PG8_WAIT_L(0); PG8_MMA(0, 1, At, B1); PG8_BAR;
            PG8_LDA(At, 0, 1); PG8_STAGE(PG8_SA(0, 0), a2, voffA);
            PG8_BAR; PG8_WAIT_L(0); PG8_MMA(1, 0, At, B0); PG8_BAR; PG8_SCHED;
            PG8_STAGE(PG8_SB(0, 1), b2 + hstep, voffB);
            PG8_WAIT_V(6); PG8_BAR; PG8_MMA(1, 1, At, B1); PG8_BAR;
            PG8_LDB(B0, 1, 0); PG8_SCHED; PG8_LDA(At, 1, 0); PG8_STAGE(PG8_SA(0, 1), a2 + hstep, voffA);
            PG8_WAIT_L(8); PG8_BAR; PG8_WAIT_L(0); PG8_MMA(0, 0, At, B0); PG8_BAR; PG8_SCHED;
            PG8_LDB(B1, 1, 1); PG8_STAGE(PG8_SB(1, 0), b3, voffB);
            PG8_BAR; PG8_WAIT_L(0); PG8_MMA(0, 1, At, B1); PG8_BAR;
            PG8_LDA(At, 1, 1); PG8_STAGE(PG8_SA(1, 0), a3, voffA);
            PG8_BAR; PG8_WAIT_L(0); PG8_MMA(1, 0, At, B0); PG8_BAR; PG8_SCHED;
            PG8_STAGE(PG8_SB(1, 1), b3 + hstep, voffB);
            PG8_WAIT_V(6); PG8_BAR; PG8_MMA(1, 1, At, B1); PG8_BAR;
            }
        }
        if constexpr (ALIGN_EPI) { if (wr == 0) PG8_BAR; }
        if constexpr (!Epi::AFTER_DRAIN) { E(acc, cur, wr, wc, fr, fq); S.done(cur); }
        if (!has_next) break;
#pragma unroll
        for (int a = 0; a < 2; ++a)
#pragma unroll
            for (int b = 0; b < 2; ++b)
#pragma unroll
                for (int m = 0; m < 4; ++m)
#pragma unroll
                    for (int n = 0; n < 2; ++n) acc[a][b][m][n] = (f32x4){zf_, zf_, zf_, zf_};
        cur = nxt; cA = nA; cB = nB; ++ui;
        if constexpr (ALIGN_EPI) { if (wr == 1) PG8_BAR; }
    }
    PG8_WAIT_V(0);
    if constexpr (!ALIGN_EPI) { if (wr == 0) PG8_BAR; }
    PG8_BAR;
    if constexpr (Epi::AFTER_DRAIN) { E.fused(acc, cur, wr, wc, fr, fq, lds, wid, lane); S.done(cur); }
#undef PG8_SA
#undef PG8_SB
#undef PG8_STAGE
#undef PG8_LDA
#undef PG8_LDB
#undef PG8_MMA
#undef PG8_WAIT_V
#undef PG8_WAIT_L
#undef PG8_BAR
#undef PG8_SCHED
}
}
constexpr int NWAVES = 8, NTHR = NWAVES * 64;
constexpr int NB = 8, SEQ = 4096, T = NB * SEQ, D = 1024, DEPTH = 4;
constexpr int DIN = 3468, DINP = 3584;
constexpr int C_GQ = 0, C_GK = 384, C_GV = 768, C_GZ = 1152, C_DQ = 1536, C_DK = 1920, C_DV = 2304, C_SQ = 2688, C_SK = 2944, C_SV = 3200, C_GA = 3456, C_GB = 3462;
constexpr int DFF = 2816, MFF = 3584, NE = 8, PLE = 256;
constexpr int MROWS = 2 * T + 2048;
constexpr float EPS = 1e-6f;
constexpr size_t MiB = 1u << 20;
constexpr size_t WS_CTL = 0, CTL_ZERO_BYTES = 1 * MiB;
constexpr size_t WS_WIN = 1 * MiB;
constexpr size_t WS_WOUT = 29 * MiB;
constexpr size_t WS_WGATE = 37 * MiB;
constexpr size_t WS_WPROJ = 45 * MiB;
constexpr size_t WS_WF13 = 47 * MiB;
constexpr size_t WS_WF2 = 69 * MiB;
constexpr size_t WS_WM13 = 80 * MiB;
constexpr size_t WS_WM2 = 304 * MiB;
constexpr size_t WS_HN = 416 * MiB;
constexpr size_t WS_U = 480 * MiB;
constexpr size_t WS_PROJ = WS_U;
constexpr size_t WS_OMIX = WS_U + 224 * MiB;
constexpr size_t WS_GDN = WS_U + 288 * MiB;
constexpr size_t WS_DSW = WS_U + 408 * MiB;
constexpr size_t WS_ACT = WS_U;
constexpr size_t WS_ASORT = WS_U;
constexpr size_t WS_MACT = WS_U + 132 * MiB;
constexpr size_t WS_POUT = WS_U + 132 * MiB;
constexpr size_t WS_PB = WS_U + 196 * MiB;
constexpr size_t WS_ROUTE = 1074 * MiB;
constexpr size_t WS_END = 1075 * MiB;
static_assert(WS_MACT + (size_t)MROWS * MFF * 2 <= WS_ROUTE && WS_ASORT + (size_t)MROWS * D * 2 <= WS_MACT, "d_ws map");
constexpr int CW_BAR = 4096;
constexpr int RING_OFF = 0, RING_BYTES = 131072;
constexpr int LDSCTL_OFF = RING_BYTES, MISC_OFF = LDSCTL_OFF + 320;
constexpr int TILEE_OFF = LDSCTL_OFF + 1024;
constexpr int LDS_BYTES = 147456;
#define GAS __attribute__((address_space(1)))
#define LAS __attribute__((address_space(3)))
typedef unsigned short bf16;
typedef unsigned v4u __attribute__((ext_vector_type(4)));
typedef float f32x4 __attribute__((ext_vector_type(4)));
typedef short bf16x8 __attribute__((ext_vector_type(8)));
typedef GAS unsigned gu32;
typedef GAS unsigned long long gu64;
#define RLX_AGENT __ATOMIC_RELAXED, __HIP_MEMORY_SCOPE_AGENT
#define LDS_WAIT() asm volatile("s_waitcnt lgkmcnt(0)" ::: "memory")
#define VM_WAIT() asm volatile("s_waitcnt vmcnt(0)" ::: "memory")
__device__ __forceinline__ unsigned long long rt() { return __builtin_amdgcn_s_memrealtime(); }
__device__ __forceinline__ unsigned f2bf(float f) { unsigned u = __builtin_bit_cast(unsigned, f); return (u + 0x7fffu + ((u >> 16) & 1u)) >> 16; }
__device__ __forceinline__ unsigned pk2(float lo, float hi) { return f2bf(lo) | (f2bf(hi) << 16); }

#define XB_TMO      128
#define XB_XCNT(j)  (256  + 64 * (j))
#define XB_XSUB(j)  (1280 + 64 * (j))
#define XB_XGEN(j)  (2304 + 64 * (j))
#define XB_TOP      3328
#define XB_TOPGEN   3392
#define XCD_BAR_WORDS 3456
#define XB_SPIN_CAP (1u << 22)

__device__ __forceinline__ unsigned xb_ld(unsigned* p)              { return __hip_atomic_load(p, __ATOMIC_RELAXED, __HIP_MEMORY_SCOPE_AGENT); }
__device__ __forceinline__ unsigned xb_add(unsigned* p, unsigned v) { return __hip_atomic_fetch_add(p, v, __ATOMIC_RELAXED, __HIP_MEMORY_SCOPE_AGENT); }
__device__ __forceinline__ unsigned xb_xcc_id() { return (unsigned)__builtin_amdgcn_s_getreg((3 << 11) | 20) & 0xFu; }
#define XB_SPIN(cond, bar) do { unsigned _sp = 0; while (cond) { __builtin_amdgcn_s_sleep(1); \
    if ((++_sp & 255u) == 0u) { if (xb_ld(&(bar)[XB_TMO])) break; if (_sp > XB_SPIN_CAP) { atomicAdd(&(bar)[XB_TMO], 1u); break; } } } } while (0)

struct XcdBarrier {
    unsigned* bar; unsigned x;
    volatile LAS unsigned* st;
};

__device__ __forceinline__ XcdBarrier xcd_barrier_post(unsigned* bar, volatile LAS unsigned* st) {
    XcdBarrier b; b.bar = bar; b.x = xb_xcc_id(); b.st = st;
    if (threadIdx.x == 0) (void)xb_add(&bar[XB_XCNT(b.x)], 1u);
    return b;
}
__device__ __forceinline__ void xcd_barrier_complete(unsigned* bar, unsigned x, unsigned& nloc, unsigned& nx) {
    const unsigned G = gridDim.x * gridDim.y * gridDim.z;
    unsigned sum, cnt, mine, sp = 0u;
    for (;;) {
        sum = 0u; cnt = 0u; mine = 0u;
#pragma unroll
        for (unsigned j = 0; j < 16; ++j) { const unsigned c = xb_ld(&bar[XB_XCNT(j)]); sum += c; cnt += (c > 0u) ? 1u : 0u; mine = (j == x) ? c : mine; }
        if (sum == G) break;
        __builtin_amdgcn_s_sleep(1);
        if ((++sp & 255u) == 0u) { if (xb_ld(&bar[XB_TMO])) break; if (sp > XB_SPIN_CAP) { atomicAdd(&bar[XB_TMO], 1u); break; } }
    }
    nloc = mine > 0u ? mine : 1u; nx = cnt > 0u ? cnt : 1u;
}

__device__ __forceinline__ void xcd_barrier(const XcdBarrier& b) {
    asm volatile("s_waitcnt vmcnt(0)" ::: "memory");
    __syncthreads();
    if (threadIdx.x == 0) {
        unsigned* bar = b.bar;
        __builtin_amdgcn_s_waitcnt(0);
        unsigned nloc = b.st[0], nx = b.st[1];
        if (nloc == 0u) { xcd_barrier_complete(bar, b.x, nloc, nx); b.st[0] = nloc; b.st[1] = nx; }
        const unsigned old = xb_add(&bar[XB_XSUB(b.x)], 1u);
        const unsigned gen = old / nloc;
        if (old + 1u == (gen + 1u) * nloc) {
            __builtin_amdgcn_fence(__ATOMIC_RELEASE, "agent");
            asm volatile("s_waitcnt vmcnt(0)" ::: "memory");
            const unsigned og = xb_add(&bar[XB_TOP], 1u);
            const unsigned tg = og / nx;
            if (og + 1u == (tg + 1u) * nx) xb_add(&bar[XB_TOPGEN], 1u);
            else XB_SPIN(xb_ld(&bar[XB_TOPGEN]) == tg, bar);
            __builtin_amdgcn_fence(__ATOMIC_ACQUIRE, "agent");
            xb_add(&bar[XB_XGEN(b.x)], 1u);
            asm volatile("s_waitcnt vmcnt(0)" ::: "memory");
        } else {
            XB_SPIN(xb_ld(&bar[XB_XGEN(b.x)]) == gen, bar);
            __builtin_amdgcn_fence(__ATOMIC_ACQUIRE, "agent");
            asm volatile("s_waitcnt vmcnt(0)" ::: "memory");
        }
    }
    __syncthreads();
}
typedef unsigned u32x2 __attribute__((ext_vector_type(2)));
__device__ __forceinline__ float bf2f(bf16 u) { return __uint_as_float((unsigned)u << 16); }
__device__ __forceinline__ float bflo(unsigned u) { return __uint_as_float(u << 16); }
__device__ __forceinline__ float bfhi(unsigned u) { return __uint_as_float(u & 0xffff0000u); }
#define SWZ_XOR(v, k) __int_as_float(__builtin_amdgcn_ds_swizzle(__float_as_int(v), ((k) << 10) | 0x1f))
__device__ __forceinline__ float wave_sum(float v) {
    v += SWZ_XOR(v, 1); v += SWZ_XOR(v, 2); v += SWZ_XOR(v, 4); v += SWZ_XOR(v, 8); v += SWZ_XOR(v, 16);
    const auto rr = __builtin_amdgcn_permlane32_swap(__float_as_uint(v), __float_as_uint(v), false, false);
    return __uint_as_float(rr[0]) + __uint_as_float(rr[1]);
}
__device__ __forceinline__ float wave_max(float v) {
    v = fmaxf(v, SWZ_XOR(v, 1)); v = fmaxf(v, SWZ_XOR(v, 2)); v = fmaxf(v, SWZ_XOR(v, 4)); v = fmaxf(v, SWZ_XOR(v, 8)); v = fmaxf(v, SWZ_XOR(v, 16));
    const auto rr = __builtin_amdgcn_permlane32_swap(__float_as_uint(v), __float_as_uint(v), false, false);
    return fmaxf(__uint_as_float(rr[0]), __uint_as_float(rr[1]));
}
__device__ __forceinline__ float silu_f(float x) { return x / (1.0f + __expf(-x)); }
__device__ __forceinline__ float sigm_f(float x) { return 1.0f / (1.0f + __expf(-x)); }
__device__ __forceinline__ float softplus_f(float x) { return x > 20.f ? x : log1pf(__expf(x)); }
__device__ __forceinline__ float rdlane(float v, int l) { return __int_as_float(__builtin_amdgcn_readlane(__float_as_int(v), l)); }

#define CAS __attribute__((address_space(4)))
struct Args { const float* in[23]; float* out; unsigned char* ws; };

struct MapIn { const float* W;
    __device__ __forceinline__ float operator()(int k, int n) const { const int o = n < 1536 ? n : (n < 3456 ? n + 12 : (n < 3468 ? 1536 + (n - 3456) : -1)); return o >= 0 ? W[(size_t)k * DIN + o] : 0.f; } };
struct MapPlain { const float* W; int N;
    __device__ __forceinline__ float operator()(int k, int n) const { return W[(size_t)k * N + n]; } };
template <class Map>
__device__ __forceinline__ void tr_item(const Map& map, int K, bf16* WT, LAS float* scr, int kb, int nb, int lane, int drow0 = -1) {
    const int k0 = 64 * kb, n0 = 32 * nb; const int d0 = drow0 < 0 ? n0 : drow0;
#pragma unroll 8
    for (int i = 0; i < 32; ++i) { const int kk = 2 * i + (lane >> 5); scr[kk * 33 + (lane & 31)] = map(k0 + kk, n0 + (lane & 31)); }
    LDS_WAIT(); asm volatile("" ::: "memory");
    const int c = lane & 7;
#pragma unroll
    for (int j = 0; j < 4; ++j) { const int n = (lane >> 3) + 8 * j; const LAS float* s = scr + (8 * c) * 33 + n;
        v4u o; o.x = pk2(s[0 * 33], s[1 * 33]); o.y = pk2(s[2 * 33], s[3 * 33]); o.z = pk2(s[4 * 33], s[5 * 33]); o.w = pk2(s[6 * 33], s[7 * 33]);
        *(GAS v4u*)(WT + (size_t)(d0 + n) * K + k0 + 8 * c) = o; }
    LDS_WAIT(); asm volatile("" ::: "memory");
}
__device__ __forceinline__ void prologue_phase(const CAS Args* a, LAS unsigned char* lds, int gw, int NGW, int wave, int lane) {
    LAS float* scr = (LAS float*)(lds + RING_OFF + wave * 16384);
    constexpr int I_IN = 16 * (DINP / 32), I_OUT = 16 * 32, I_GATE = 16 * 32, I_PROJ = 4 * 32, I_L = I_IN + I_OUT + I_GATE + I_PROJ;
    constexpr int I_F13 = 16 * (2 * DFF / 32), I_F2 = (DFF / 64) * 32, I_F = I_F13 + I_F2;
    constexpr int I_M13 = 16 * (2 * MFF / 32), I_M2 = (MFF / 64) * 32, I_M = I_M13 + I_M2;
    constexpr int NITEMS = 4 * I_L + 2 * I_F + 16 * I_M;
    unsigned char* ws = (unsigned char*)a->ws;
    for (int it0 = gw; it0 < NITEMS; it0 += NGW) {
        int it = it0;
        if (it < 4 * I_L) { const int l = it / I_L; int r = it % I_L;
            if (r < I_IN) { MapIn m{a->in[3] + (size_t)l * D * DIN}; tr_item(m, D, (bf16*)(ws + WS_WIN) + (size_t)l * DINP * D, scr, r / (DINP / 32), r % (DINP / 32), lane); continue; } r -= I_IN;
            if (r < I_OUT) { MapPlain m{a->in[10] + (size_t)l * D * D, D}; tr_item(m, D, (bf16*)(ws + WS_WOUT) + (size_t)l * D * D, scr, r / 32, r % 32, lane); continue; } r -= I_OUT;
            if (r < I_GATE) { MapPlain m{a->in[21] + (size_t)l * D * D, D}; tr_item(m, D, (bf16*)(ws + WS_WGATE) + (size_t)l * D * D, scr, r / 32, r % 32, lane); continue; } r -= I_GATE;
            { MapPlain m{a->in[19] + (size_t)l * PLE * D, D}; tr_item(m, PLE, (bf16*)(ws + WS_WPROJ) + (size_t)l * D * PLE, scr, r / 32, r % 32, lane); continue; }
        }
        it -= 4 * I_L;
        if (it < 2 * I_F) { const int j = it / I_F; int r = it % I_F;
            if (r < I_F13) { const int half = r / (I_F13 / 2), rr = r % (I_F13 / 2), kb = rr / (DFF / 32), nb = rr % (DFF / 32);
                MapPlain m{a->in[12 + half] + (size_t)j * D * DFF, DFF}; tr_item(m, D, (bf16*)(ws + WS_WF13) + (size_t)j * 2 * DFF * D, scr, kb, nb, lane, ((32 * nb) >> 7) * 256 + ((32 * nb) & 127) + 128 * half); continue; } r -= I_F13;
            { MapPlain m{a->in[14] + (size_t)j * DFF * D, D}; tr_item(m, DFF, (bf16*)(ws + WS_WF2) + (size_t)j * D * DFF, scr, r / 32, r % 32, lane); continue; }
        }
        it -= 2 * I_F;
        { const int je = it / I_M; int r = it % I_M;
            if (r < I_M13) { const int half = r / (I_M13 / 2), rr = r % (I_M13 / 2), kb = rr / (MFF / 32), nb = rr % (MFF / 32);
                MapPlain m{a->in[16 + half] + (size_t)je * D * MFF, MFF}; tr_item(m, D, (bf16*)(ws + WS_WM13) + (size_t)je * 2 * MFF * D, scr, kb, nb, lane, ((32 * nb) >> 7) * 256 + ((32 * nb) & 127) + 128 * half); continue; } r -= I_M13;
            { MapPlain m{a->in[18] + (size_t)je * MFF * D, D}; tr_item(m, MFF, (bf16*)(ws + WS_WM2) + (size_t)je * D * MFF, scr, r / 32, r % 32, lane); }
        }
    }
}

__device__ __forceinline__ void norm_phase(const float* hin, float* hw, const float* w, bf16* hn,
                                           const bf16* ysort, const int* pos, const float* gate,
                                           bool do_route, const LAS float* rlds, int* tok_e, float* tok_g,
                                           int gw, int NGW, int lane) {
    f32x4 wv[4];
#pragma unroll
    for (int j = 0; j < 4; ++j) wv[j] = *(const f32x4*)(w + 4 * lane + 256 * j);
    for (int m = gw; m < T; m += NGW) {
        const float* xr = hin + (size_t)m * D + 4 * lane;
        f32x4 v[4];
#pragma unroll
        for (int j = 0; j < 4; ++j) v[j] = *(const f32x4*)(xr + 256 * j);
        if (ysort) {
            const int p1 = pos[2 * m], p2 = pos[2 * m + 1]; const float g1 = gate[2 * m], g2 = gate[2 * m + 1];
            const bf16* y1 = ysort + (size_t)p1 * D + 4 * lane; const bf16* y2 = ysort + (size_t)p2 * D + 4 * lane;
#pragma unroll
            for (int j = 0; j < 4; ++j) { const u32x2 a1 = *(const u32x2*)(y1 + 256 * j), a2 = *(const u32x2*)(y2 + 256 * j);
                v[j][0] += g1 * bflo(a1.x) + g2 * bflo(a2.x); v[j][1] += g1 * bfhi(a1.x) + g2 * bfhi(a2.x); v[j][2] += g1 * bflo(a1.y) + g2 * bflo(a2.y); v[j][3] += g1 * bfhi(a1.y) + g2 * bfhi(a2.y);
                *(f32x4*)(hw + (size_t)m * D + 4 * lane + 256 * j) = v[j]; }
        }
        float s = 0.f;
#pragma unroll
        for (int j = 0; j < 4; ++j) s += (v[j][0] * v[j][0] + v[j][1] * v[j][1]) + (v[j][2] * v[j][2] + v[j][3] * v[j][3]);
        const float r = rsqrtf(wave_sum(s) * (1.0f / D) + EPS);
        bf16* orow = hn + (size_t)m * D + 4 * lane;
#pragma unroll
        for (int j = 0; j < 4; ++j) { v[j] = v[j] * r * wv[j]; u32x2 o; o.x = pk2(v[j][0], v[j][1]); o.y = pk2(v[j][2], v[j][3]); *(u32x2*)(orow + 256 * j) = o; }
        if (do_route) {
            float lg[8];
#pragma unroll
            for (int e = 0; e < 8; ++e) lg[e] = 0.f;
#pragma unroll
            for (int j = 0; j < 4; ++j)
#pragma unroll
                for (int i = 0; i < 4; ++i) { const LAS f32x4* rp = (const LAS f32x4*)(rlds + (size_t)(4 * lane + 256 * j + i) * 8); const f32x4 r0 = rp[0], r1 = rp[1]; const float y = v[j][i];
                    lg[0] += y * r0[0]; lg[1] += y * r0[1]; lg[2] += y * r0[2]; lg[3] += y * r0[3]; lg[4] += y * r1[0]; lg[5] += y * r1[1]; lg[6] += y * r1[2]; lg[7] += y * r1[3]; }
#pragma unroll
            for (int e = 0; e < 8; ++e) lg[e] = wave_sum(lg[e]);
            int i1 = 0; float v1 = lg[0];
#pragma unroll
            for (int e = 1; e < 8; ++e) if (lg[e] > v1) { v1 = lg[e]; i1 = e; }
            int i2 = -1; float v2 = -3.0e38f;
#pragma unroll
            for (int e = 0; e < 8; ++e) if (e != i1 && lg[e] > v2) { v2 = lg[e]; i2 = e; }
            const float g1 = 1.0f / (1.0f + __expf(v2 - v1));
            if (lane == 0) { tok_e[m] = i1 | (i2 << 8); tok_g[2 * m] = g1; tok_g[2 * m + 1] = 1.0f - g1; }
        }
    }
}

__device__ __forceinline__ void moe_gather_phase(const int* tok_e, int* pos, const bf16* hn, bf16* asort, LAS unsigned char* lds, int gw, int NGW, int wave, int lane, int tid) {
    LAS unsigned long long* cnt64 = (LAS unsigned long long*)(lds + RING_OFF);
    LAS int* pre = (LAS int*)(lds + RING_OFF + 4096);
    LAS int* tab = (LAS int*)(lds + TILEE_OFF);
    for (int gi = 0; gi < 64; ++gi) { const int g = wave * 64 + gi; const int ev = tok_e[g * 64 + lane]; const int e1 = ev & 7, e2 = (ev >> 8) & 7;
        unsigned long long c = 0ull;
#pragma unroll
        for (int e = 0; e < 8; ++e) { const unsigned long long mk = __ballot(e1 == e || e2 == e); c |= (unsigned long long)__popcll(mk) << (8 * e); }
        if (lane == 0) cnt64[g] = c; }
    __syncthreads();
    if (tid < 8) { int run = 0; for (int g = 0; g < 512; ++g) { pre[g * 8 + tid] = run; run += (int)((cnt64[g] >> (8 * tid)) & 0xffull); } tab[320 + tid] = run; }
    __syncthreads();
    if (tid == 0) { int off = 0; for (int e = 0; e < 8; ++e) { tab[304 + e] = off; const int np = (tab[320 + e] + 255) >> 8; for (int i = 0; i < np; ++i) ((volatile LAS int*)tab)[(off >> 8) + i] = e; off += np << 8; } tab[312] = off; tab[300] = off; }
    __syncthreads();
    for (int u = gw; u < 1024; u += NGW) { const int g = u >> 1, c = u & 1; const int t = g * 64 + lane; const int ev = tok_e[t]; const int e1 = ev & 7, e2 = (ev >> 8) & 7; const int em = c ? e2 : e1;
        int rank = 0; const unsigned long long lt = (1ull << lane) - 1ull;
#pragma unroll
        for (int e = 0; e < 8; ++e) { const unsigned long long mk = __ballot(e1 == e || e2 == e); if (em == e) rank = __popcll(mk & lt); }
        const int slot = tab[304 + em] + pre[g * 8 + em] + rank;
        pos[2 * t + c] = slot;
        for (int i = 0; i < 64; ++i) { const int dst = __builtin_amdgcn_readlane(slot, i); const v4u* src = (const v4u*)(hn + (size_t)(g * 64 + i) * D); v4u* d = (v4u*)(asort + (size_t)dst * D);
            const v4u x0 = src[lane], x1 = src[64 + lane]; d[lane] = x0; d[64 + lane] = x1; } }
    for (int e = 0; e < 8; ++e) { const int r0 = tab[304 + e] + tab[320 + e], r1 = tab[305 + e];
        for (int r = r0 + gw; r < r1; r += NGW) { v4u* d = (v4u*)(asort + (size_t)r * D); unsigned z0 = 0u; asm volatile("" : "+v"(z0)); const v4u z = {z0, z0, z0, z0}; d[lane] = z; d[64 + lane] = z; } }
}
__device__ __forceinline__ void naive_gdn_unit(int bh, int layer, const float* convw, const float* alog, const float* dtbias, const float* gnw, const bf16* PROJ, bf16* OMIX, int lane) {
    const int b = bh / 6, h = bh % 6;
    const float* cw = convw + (size_t)layer * 4 * 1152;
    float cq[4], ck[4], cv[4];
#pragma unroll
    for (int w = 0; w < 4; ++w) { cq[w] = cw[w * 1152 + h * 64 + lane]; ck[w] = cw[w * 1152 + 384 + h * 64 + lane]; cv[w] = cw[w * 1152 + 768 + h * 64 + lane]; }
    const float Aexp = expf(alog[layer * 6 + h]), dtb = dtbias[layer * 6 + h], nw = gnw[layer * 64 + lane];
    float S[64];
#pragma unroll
    for (int d = 0; d < 64; ++d) S[d] = 0.f;
    float hq0 = 0.f, hq1 = 0.f, hq2 = 0.f, hk0 = 0.f, hk1 = 0.f, hk2 = 0.f, hv0 = 0.f, hv1 = 0.f, hv2 = 0.f;
    const bf16* row = PROJ + (size_t)(b * SEQ) * DINP;
    bf16* orow = OMIX + (size_t)(b * SEQ) * D + h * 64 + lane;
    for (int t = 0; t < SEQ; ++t, row += DINP, orow += D) {
        const float xq = bf2f(row[C_GQ + h * 64 + lane]), xk = bf2f(row[C_GK + h * 64 + lane]), xv = bf2f(row[C_GV + h * 64 + lane]);
        float q = cq[0] * hq0 + cq[1] * hq1 + cq[2] * hq2 + cq[3] * xq; hq0 = hq1; hq1 = hq2; hq2 = xq;
        float k = ck[0] * hk0 + ck[1] * hk1 + ck[2] * hk2 + ck[3] * xk; hk0 = hk1; hk1 = hk2; hk2 = xk;
        float v = cv[0] * hv0 + cv[1] * hv1 + cv[2] * hv2 + cv[3] * xv; hv0 = hv1; hv1 = hv2; hv2 = xv;
        q = silu_f(q); k = silu_f(k); v = silu_f(v);
        const float qn = q * rsqrtf(wave_sum(q * q) + EPS), kn = k * rsqrtf(wave_sum(k * k) + EPS);
        const float al = bf2f(row[C_GA + h]), bl = bf2f(row[C_GB + h]);
        const float alpha = __expf(-Aexp * softplus_f(al + dtb)), beta = sigm_f(bl);
        float d0 = 0.f, d1 = 0.f, d2 = 0.f, d3 = 0.f;
#pragma unroll
        for (int d = 0; d < 64; d += 4) { S[d] *= alpha; S[d + 1] *= alpha; S[d + 2] *= alpha; S[d + 3] *= alpha;
            d0 += rdlane(kn, d) * S[d]; d1 += rdlane(kn, d + 1) * S[d + 1]; d2 += rdlane(kn, d + 2) * S[d + 2]; d3 += rdlane(kn, d + 3) * S[d + 3]; }
        const float r = beta * (v - ((d0 + d1) + (d2 + d3)));
        float o0 = 0.f, o1 = 0.f, o2 = 0.f, o3 = 0.f;
#pragma unroll
        for (int d = 0; d < 64; d += 4) { S[d] += rdlane(kn, d) * r; S[d + 1] += rdlane(kn, d + 1) * r; S[d + 2] += rdlane(kn, d + 2) * r; S[d + 3] += rdlane(kn, d + 3) * r;
            o0 += rdlane(qn, d) * S[d]; o1 += rdlane(qn, d + 1) * S[d + 1]; o2 += rdlane(qn, d + 2) * S[d + 2]; o3 += rdlane(qn, d + 3) * S[d + 3]; }
        const float o = ((o0 + o1) + (o2 + o3)) * 0.125f;
        const float y = o * rsqrtf(wave_sum(o * o) * (1.0f / 64.0f) + EPS) * nw;
        const float z = bf2f(row[C_GZ + h * 64 + lane]);
        *orow = (bf16)f2bf(y * silu_f(z));
    }
}
__device__ __forceinline__ void naive_sb_unit(int u, int layer, const float* sbnw, const bf16* PROJ, bf16* OMIX, LAS unsigned char* wl  , int lane) {
    const int bh = u >> 6, qg = 63 - (u & 63);
    const int b = bh >> 2, h = bh & 3, q0 = qg * 64, t = q0 + lane;
    const bf16* base = PROJ + (size_t)(b * SEQ) * DINP;
    float q[64], o[64];
    { const v4u* qp = (const v4u*)(base + (size_t)t * DINP + C_SQ + h * 64);
#pragma unroll
      for (int j = 0; j < 8; ++j) { const v4u x = qp[j]; q[8 * j] = bflo(x.x) * 0.125f; q[8 * j + 1] = bfhi(x.x) * 0.125f; q[8 * j + 2] = bflo(x.y) * 0.125f; q[8 * j + 3] = bfhi(x.y) * 0.125f;
          q[8 * j + 4] = bflo(x.z) * 0.125f; q[8 * j + 5] = bfhi(x.z) * 0.125f; q[8 * j + 6] = bflo(x.w) * 0.125f; q[8 * j + 7] = bfhi(x.w) * 0.125f; } }
#pragma unroll
    for (int d = 0; d < 64; ++d) o[d] = 0.f;
    float cum = 0.f;
    LAS v4u* kt = (LAS v4u*)wl; LAS v4u* vt = (LAS v4u*)(wl + 8192);
    for (int kt0 = q0; kt0 >= 0; kt0 -= 64) {
        { const v4u* kp = (const v4u*)(base + (size_t)(kt0 + lane) * DINP + C_SK + h * 64); const v4u* vp = (const v4u*)(base + (size_t)(kt0 + lane) * DINP + C_SV + h * 64);
#pragma unroll
          for (int j = 0; j < 8; ++j) { kt[lane * 8 + j] = kp[j]; vt[lane * 8 + j] = vp[j]; } }
        LDS_WAIT(); asm volatile("" ::: "memory");
        for (int si = 63; si >= 0; --si) {
            const int s = kt0 + si;
            float z0 = 0.f, z1 = 0.f;
#pragma unroll
            for (int j = 0; j < 8; ++j) { const v4u x = kt[si * 8 + j];
                z0 += q[8 * j] * bflo(x.x) + q[8 * j + 2] * bflo(x.y) + q[8 * j + 4] * bflo(x.z) + q[8 * j + 6] * bflo(x.w);
                z1 += q[8 * j + 1] * bfhi(x.x) + q[8 * j + 3] * bfhi(x.y) + q[8 * j + 5] * bfhi(x.z) + q[8 * j + 7] * bfhi(x.w); }
            const float z = z0 + z1; const bool valid = s < t;
            const float sp = softplus_f(z);
            const float p = valid ? __expf(z - sp - cum) : 0.f;
            cum += valid ? sp : 0.f;
#pragma unroll
            for (int j = 0; j < 8; ++j) { const v4u x = vt[si * 8 + j];
                o[8 * j] += p * bflo(x.x); o[8 * j + 1] += p * bfhi(x.x); o[8 * j + 2] += p * bflo(x.y); o[8 * j + 3] += p * bfhi(x.y);
                o[8 * j + 4] += p * bflo(x.z); o[8 * j + 5] += p * bfhi(x.z); o[8 * j + 6] += p * bflo(x.w); o[8 * j + 7] += p * bfhi(x.w); }
        }
        LDS_WAIT(); asm volatile("" ::: "memory");
    }
    float ss = 0.f;
#pragma unroll
    for (int d = 0; d < 64; ++d) ss += o[d] * o[d];
    const float r = rsqrtf(ss * (1.0f / 64.0f) + EPS);
    const float* nw = sbnw + layer * 64;
    v4u* op = (v4u*)(OMIX + (size_t)(b * SEQ + t) * D + 768 + h * 64);
#pragma unroll
    for (int j = 0; j < 8; ++j) { v4u w; w.x = pk2(o[8 * j] * r * nw[8 * j], o[8 * j + 1] * r * nw[8 * j + 1]); w.y = pk2(o[8 * j + 2] * r * nw[8 * j + 2], o[8 * j + 3] * r * nw[8 * j + 3]);
        w.z = pk2(o[8 * j + 4] * r * nw[8 * j + 4], o[8 * j + 5] * r * nw[8 * j + 5]); w.w = pk2(o[8 * j + 6] * r * nw[8 * j + 6], o[8 * j + 7] * r * nw[8 * j + 7]); op[j] = w; }
}
__device__ __forceinline__ void naive_dsw_unit(int u, int layer, const float* dswnw, const bf16* PROJ, bf16* OMIX, int lane) {
    const int bh = u >> 6, tg = u & 63; const int b = bh / 6, h = bh % 6, t = tg * 64 + lane;
    const bf16* base = PROJ + (size_t)(b * SEQ) * DINP;
    const float slope = exp2f(-8.0f * (float)(h + 1) / 6.0f);
    float q[64], o[64];
    { const v4u* qp = (const v4u*)(base + (size_t)t * DINP + C_DQ + h * 64);
#pragma unroll
      for (int j = 0; j < 8; ++j) { const v4u x = qp[j]; q[8 * j] = bflo(x.x) * 0.125f; q[8 * j + 1] = bfhi(x.x) * 0.125f; q[8 * j + 2] = bflo(x.y) * 0.125f; q[8 * j + 3] = bfhi(x.y) * 0.125f;
          q[8 * j + 4] = bflo(x.z) * 0.125f; q[8 * j + 5] = bfhi(x.z) * 0.125f; q[8 * j + 6] = bflo(x.w) * 0.125f; q[8 * j + 7] = bfhi(x.w) * 0.125f; } }
#pragma unroll
    for (int d = 0; d < 64; ++d) o[d] = 0.f;
    float mx = -3.0e38f, l = 0.f;
    for (int cfg = 0; cfg < 3; ++cfg) { const int r = cfg == 0 ? 1 : (cfg == 1 ? 4 : 16);
        for (int j = 0; j <= 128; ++j) { const int kp = t - j * r;
            if (kp >= 0) {
                const v4u* kq = (const v4u*)(base + (size_t)kp * DINP + C_DK + h * 64); const v4u* vq = (const v4u*)(base + (size_t)kp * DINP + C_DV + h * 64);
                float z0 = 0.f, z1 = 0.f;
#pragma unroll
                for (int jj = 0; jj < 8; ++jj) { const v4u x = kq[jj];
                    z0 += q[8 * jj] * bflo(x.x) + q[8 * jj + 2] * bflo(x.y) + q[8 * jj + 4] * bflo(x.z) + q[8 * jj + 6] * bflo(x.w);
                    z1 += q[8 * jj + 1] * bfhi(x.x) + q[8 * jj + 3] * bfhi(x.y) + q[8 * jj + 5] * bfhi(x.z) + q[8 * jj + 7] * bfhi(x.w); }
                const float s = z0 + z1 - slope * (float)(j * r);
                const float mn = fmaxf(mx, s); const float sc = __expf(mx - mn), p = __expf(s - mn); mx = mn; l = l * sc + p;
#pragma unroll
                for (int jj = 0; jj < 8; ++jj) { const v4u x = vq[jj];
                    o[8 * jj] = o[8 * jj] * sc + p * bflo(x.x); o[8 * jj + 1] = o[8 * jj + 1] * sc + p * bfhi(x.x); o[8 * jj + 2] = o[8 * jj + 2] * sc + p * bflo(x.y); o[8 * jj + 3] = o[8 * jj + 3] * sc + p * bfhi(x.y);
                    o[8 * jj + 4] = o[8 * jj + 4] * sc + p * bflo(x.z); o[8 * jj + 5] = o[8 * jj + 5] * sc + p * bfhi(x.z); o[8 * jj + 6] = o[8 * jj + 6] * sc + p * bflo(x.w); o[8 * jj + 7] = o[8 * jj + 7] * sc + p * bfhi(x.w); }
            }
        }
    }
    const float il = 1.0f / l; float ss = 0.f;
#pragma unroll
    for (int d = 0; d < 64; ++d) { o[d] *= il; ss += o[d] * o[d]; }
    const float r = rsqrtf(ss * (1.0f / 64.0f) + EPS);
    const float* nw = dswnw + layer * 64;
    v4u* op = (v4u*)(OMIX + (size_t)(b * SEQ + t) * D + 384 + h * 64);
#pragma unroll
    for (int j = 0; j < 8; ++j) { v4u w; w.x = pk2(o[8 * j] * r * nw[8 * j], o[8 * j + 1] * r * nw[8 * j + 1]); w.y = pk2(o[8 * j + 2] * r * nw[8 * j + 2], o[8 * j + 3] * r * nw[8 * j + 3]);
        w.z = pk2(o[8 * j + 4] * r * nw[8 * j + 4], o[8 * j + 5] * r * nw[8 * j + 5]); w.w = pk2(o[8 * j + 6] * r * nw[8 * j + 6], o[8 * j + 7] * r * nw[8 * j + 7]); op[j] = w; }
}
#define LAUNDER() do { ap = (const CAS Args*)__builtin_amdgcn_kernarg_segment_ptr(); asm volatile("" : "+s"(ap)); } while (0)
#define A_IN(i) ((const float*)ap->in[i])
#define WSP ((unsigned char*)ap->ws)
#define HOUT ((float*)ap->out)
#define LDSP ((LAS unsigned char*)lds_raw)
__device__ __forceinline__ int GX() { int g = gridDim.x; asm volatile("" : "+s"(g)); return g; }
__device__ __forceinline__ int BX() { int b = blockIdx.x; asm volatile("" : "+s"(b)); return b; }
#define GRID_BAR() do { LAUNDER(); XcdBarrier b_; b_.bar = (unsigned*)(WSP + WS_CTL) + CW_BAR; b_.x = xb_xcc_id(); b_.st = (volatile LAS unsigned*)(LDSP + MISC_OFF) + 8; xcd_barrier(b_); } while (0)
#define IDS() int tid_ = wave_s * 64 + mk_lane(), bx_ = blockIdx.x, G_ = gridDim.x; asm volatile("" : "+v"(tid_), "+s"(bx_), "+s"(G_)); const int tid = tid_, lane = tid & 63, wave = __builtin_amdgcn_readfirstlane(tid >> 6); const int G = G_, bx = bx_; \
              const int vcu = (G % 8 == 0) ? (bx % 8) * (G / 8) + bx / 8 : bx; const int gw = vcu * NWAVES + wave, NGW = G * NWAVES; (void)gw; (void)NGW; (void)lane; (void)tid; (void)vcu
__global__ void __launch_bounds__(NTHR, 2) mega_fwd(Args a_by_value) {
    extern __shared__ __attribute__((aligned(16))) unsigned char lds_raw[];
    const CAS Args* ap;
    const int wave_s = __builtin_amdgcn_readfirstlane((int)threadIdx.x >> 6);
    { IDS(); for (int u = tid; u < (LDS_BYTES - LDSCTL_OFF) / 4; u += NTHR) ((LAS unsigned*)(LDSP + LDSCTL_OFF))[u] = 0u;
      __syncthreads();
      LAUNDER(); (void)xcd_barrier_post((unsigned*)(WSP + WS_CTL) + CW_BAR, (volatile LAS unsigned*)(LDSP + MISC_OFF) + 8); }

    { IDS(); LAUNDER(); prologue_phase(ap, LDSP, gw, NGW, wave, lane); }
    GRID_BAR();

    for (int layer = 0; layer < DEPTH; ++layer) {
        { IDS(); LAUNDER(); const float* hin = layer == 0 ? A_IN(0) : HOUT;
          norm_phase(hin, nullptr, A_IN(2) + layer * D, (bf16*)(WSP + WS_HN), nullptr, nullptr, nullptr, false, (const LAS float*)LDSP, nullptr, nullptr, gw, NGW, lane); }
        GRID_BAR();
        { LAUNDER(); pg8::Gemm g{(const bf16*)(WSP + WS_HN), (const bf16*)(WSP + WS_WIN) + (size_t)layer * DINP * D, T, DINP, D}; pg8::StaticOrder S; S.init(T, DINP, GX(), BX());
          pg8::EpiStore E{(bf16*)(WSP + WS_PROJ), DINP, 1 << 20};
          pg8::gemm_phase<pg8::EpiStore, pg8::StaticOrder, true, true>(LDSP + RING_OFF, g, S, E, wave_s); }
        GRID_BAR();
        { IDS(); LAUNDER(); const bf16* PROJ = (const bf16*)(WSP + WS_PROJ); bf16* OMIX = (bf16*)(WSP + WS_OMIX);
          for (int u = gw; u < 48; u += NGW) naive_gdn_unit(u, layer, A_IN(4), A_IN(5), A_IN(6), A_IN(7), PROJ, OMIX, lane);
          for (int u = gw; u < 2048; u += NGW) naive_sb_unit(u, layer, A_IN(9), PROJ, OMIX, LDSP + RING_OFF + wave * 16384, lane);
          for (int u = gw; u < 3072; u += NGW) naive_dsw_unit(u, layer, A_IN(8), PROJ, OMIX, lane);
          }
        GRID_BAR();
        { LAUNDER(); pg8::Gemm g{(const bf16*)(WSP + WS_OMIX), (const bf16*)(WSP + WS_WOUT) + (size_t)layer * D * D, T, D, D}; pg8::StaticOrder S; S.init(T, D, GX(), BX());
          pg8::EpiResid E{layer == 0 ? A_IN(0) : HOUT, HOUT, D};
          pg8::gemm_phase<pg8::EpiResid, pg8::StaticOrder, true, true>(LDSP + RING_OFF, g, S, E, wave_s); }
        GRID_BAR();
        if ((layer & 1) == 0) {
            { IDS(); LAUNDER(); norm_phase(HOUT, nullptr, A_IN(11) + layer * D, (bf16*)(WSP + WS_HN), nullptr, nullptr, nullptr, false, (const LAS float*)LDSP, nullptr, nullptr, gw, NGW, lane); }
            GRID_BAR();
            { LAUNDER(); const int j = layer >> 1; pg8::Gemm g{(const bf16*)(WSP + WS_HN), (const bf16*)(WSP + WS_WF13) + (size_t)j * 2 * DFF * D, T, 2 * DFF, D}; pg8::StaticOrder S; S.init(T, 2 * DFF, GX(), BX());
              pg8::EpiSwiGLU E{(bf16*)(WSP + WS_ACT), DFF, 1 << 20};
              pg8::gemm_phase<pg8::EpiSwiGLU, pg8::StaticOrder, true, true>(LDSP + RING_OFF, g, S, E, wave_s); }
            GRID_BAR();
            { LAUNDER(); const int j = layer >> 1; pg8::Gemm g{(const bf16*)(WSP + WS_ACT), (const bf16*)(WSP + WS_WF2) + (size_t)j * D * DFF, T, D, DFF}; pg8::StaticOrder S; S.init(T, D, GX(), BX());
              pg8::EpiResid E{HOUT, HOUT, D};
              pg8::gemm_phase<pg8::EpiResid, pg8::StaticOrder, true, true>(LDSP + RING_OFF, g, S, E, wave_s); }
            GRID_BAR();
            { IDS(); LAUNDER(); norm_phase(HOUT, nullptr, A_IN(20) + layer * D, (bf16*)(WSP + WS_HN), nullptr, nullptr, nullptr, false, (const LAS float*)LDSP, nullptr, nullptr, gw, NGW, lane); }
        } else {
            { IDS(); LAUNDER(); LAS float* rl = (LAS float*)(LDSP + RING_OFF); const float* rw = A_IN(15) + (size_t)(layer >> 1) * D * NE;
              for (int i = tid; i < D * NE; i += NTHR) rl[i] = rw[i];
              __syncthreads();
              norm_phase(HOUT, nullptr, A_IN(11) + layer * D, (bf16*)(WSP + WS_HN), nullptr, nullptr, nullptr, true, rl, (int*)(WSP + WS_ROUTE), (float*)(WSP + WS_ROUTE + 131072), gw, NGW, lane);
              __syncthreads(); }
            GRID_BAR();
            { IDS(); LAUNDER(); moe_gather_phase((const int*)(WSP + WS_ROUTE), (int*)(WSP + WS_ROUTE + 131072 + 262144), (const bf16*)(WSP + WS_HN), (bf16*)(WSP + WS_ASORT), LDSP, gw, NGW, wave, lane, tid); }
            GRID_BAR();
            { LAUNDER(); const int j = layer >> 1; const LAS int* tab = (const LAS int*)(LDSP + TILEE_OFF); const int Mp = tab[300];
              pg8::Gemm g{(const bf16*)(WSP + WS_ASORT), (const bf16*)(WSP + WS_WM13) + (size_t)j * NE * 2 * MFF * D, Mp, 2 * MFF, D}; pg8::GroupedOrder S; S.init(Mp, 2 * MFF, GX(), BX(), tab);
              pg8::EpiSwiGLU E{(bf16*)(WSP + WS_MACT), MFF, 2 * MFF / 256};
              pg8::gemm_phase<pg8::EpiSwiGLU, pg8::GroupedOrder, true, true>(LDSP + RING_OFF, g, S, E, wave_s); }
            GRID_BAR();
            { LAUNDER(); const int j = layer >> 1; const LAS int* tab = (const LAS int*)(LDSP + TILEE_OFF); const int Mp = tab[300];
              pg8::Gemm g{(const bf16*)(WSP + WS_MACT), (const bf16*)(WSP + WS_WM2) + (size_t)j * NE * D * MFF, Mp, D, MFF}; pg8::GroupedOrder S; S.init(Mp, D, GX(), BX(), tab);
              pg8::EpiStore E{(bf16*)(WSP + WS_ASORT), D, D / 256};
              pg8::gemm_phase<pg8::EpiStore, pg8::GroupedOrder, true, true>(LDSP + RING_OFF, g, S, E, wave_s); }
            GRID_BAR();
            { IDS(); LAUNDER(); norm_phase(HOUT, HOUT, A_IN(20) + layer * D, (bf16*)(WSP + WS_HN), (const bf16*)(WSP + WS_ASORT), (const int*)(WSP + WS_ROUTE + 131072 + 262144), (const float*)(WSP + WS_ROUTE + 131072), false, (const LAS float*)LDSP, nullptr, nullptr, gw, NGW, lane); }
        }
        { IDS(); LAUNDER(); const float* p = A_IN(1) + (size_t)layer * T * PLE; bf16* PB = (bf16*)(WSP + WS_PB);
          for (size_t i = (size_t)(vcu * NTHR + tid); i < (size_t)T * PLE / 8; i += (size_t)G * NTHR) { const f32x4 x0 = *(const f32x4*)(p + 8 * i), x1 = *(const f32x4*)(p + 8 * i + 4);
              v4u o; o.x = pk2(x0[0], x0[1]); o.y = pk2(x0[2], x0[3]); o.z = pk2(x1[0], x1[1]); o.w = pk2(x1[2], x1[3]); *(v4u*)(PB + 8 * i) = o; } }
        GRID_BAR();
        { LAUNDER(); pg8::Gemm g{(const bf16*)(WSP + WS_PB), (const bf16*)(WSP + WS_WPROJ) + (size_t)layer * D * PLE, T, D, PLE}; pg8::StaticOrder S; S.init(T, D, GX(), BX());
          pg8::EpiPleP E{(bf16*)(WSP + WS_POUT), D};
          pg8::gemm_phase<pg8::EpiPleP, pg8::StaticOrder, true, true>(LDSP + RING_OFF, g, S, E, wave_s); }
        { LAUNDER(); pg8::Gemm g{(const bf16*)(WSP + WS_HN), (const bf16*)(WSP + WS_WGATE) + (size_t)layer * D * D, T, D, D}; pg8::StaticOrder S; S.init(T, D, GX(), BX());
          pg8::EpiPleG E{HOUT, HOUT, (const bf16*)(WSP + WS_POUT), D};
          pg8::gemm_phase<pg8::EpiPleG, pg8::StaticOrder, true, true>(LDSP + RING_OFF, g, S, E, wave_s); }
        GRID_BAR();
    }
    { IDS(); LAUNDER(); const float* w = A_IN(22); float* H = HOUT; f32x4 wv[4];
#pragma unroll
      for (int jj = 0; jj < 4; ++jj) wv[jj] = *(const f32x4*)(w + 4 * lane + 256 * jj);
      for (int m = gw; m < T; m += NGW) { float* xr = H + (size_t)m * D + 4 * lane; f32x4 v[4]; float s = 0.f;
#pragma unroll
          for (int jj = 0; jj < 4; ++jj) { v[jj] = *(const f32x4*)(xr + 256 * jj); s += (v[jj][0] * v[jj][0] + v[jj][1] * v[jj][1]) + (v[jj][2] * v[jj][2] + v[jj][3] * v[jj][3]); }
          const float r = rsqrtf(wave_sum(s) * (1.0f / D) + EPS);
#pragma unroll
          for (int jj = 0; jj < 4; ++jj) *(f32x4*)(xr + 256 * jj) = v[jj] * r * wv[jj]; }
      if (bx == 0 && tid == 0) { if (__hip_atomic_load((gu32*)(WSP + WS_CTL) + CW_BAR + XB_TMO, RLX_AGENT) != 0u) { asm volatile("s_waitcnt vmcnt(0)" ::: "memory"); H[0] = __builtin_nanf(""); } } }
}

extern "C" void kernel_launch(void* const* d_in, const int* in_sizes, int n_in, void* d_out, int out_size, void* d_ws, size_t ws_size, hipStream_t stream) {
    static int grid = 0;
    if (grid == 0) {
        if (n_in != 23 || in_sizes[0] != T * D || out_size != T * D || ws_size < WS_END) { fprintf(stderr, "kernel_launch: unexpected shapes / workspace (n_in %d, in0 %d, out %d, ws %zu < %zu); nothing launched\n", n_in, n_in > 0 ? in_sizes[0] : -1, out_size, ws_size, (size_t)WS_END); grid = -1; return; }
        int dev = 0, cus = 0, per_cu = 0;
        if (hipGetDevice(&dev) != hipSuccess || hipDeviceGetAttribute(&cus, hipDeviceAttributeMultiprocessorCount, dev) != hipSuccess) { grid = -1; return; }
        if (hipFuncSetAttribute((const void*)mega_fwd, hipFuncAttributeMaxDynamicSharedMemorySize, LDS_BYTES) != hipSuccess) { fprintf(stderr, "kernel_launch: hipFuncSetAttribute failed\n"); grid = -1; return; }
        if (hipOccupancyMaxActiveBlocksPerMultiprocessor(&per_cu, (const void*)mega_fwd, NTHR, LDS_BYTES) != hipSuccess || per_cu < 1) { fprintf(stderr, "kernel_launch: occupancy query reports %d blocks per CU; nothing launched\n", per_cu); (void)hipGetLastError(); grid = -1; return; }
        (void)hipGetLastError();
        grid = cus;
    }
    if (grid < 0) return;
    if (hipMemsetAsync((char*)d_ws + WS_CTL, 0, CTL_ZERO_BYTES, stream) != hipSuccess) return;
    Args a{};
    for (int i = 0; i < 23; ++i) a.in[i] = (const float*)d_in[i];
    a.out = (float*)d_out; a.ws = (unsigned char*)d_ws;
    hipLaunchKernelGGL(mega_fwd, dim3(grid), dim3(NTHR), LDS_BYTES, stream, a);
}
```

```cpp
#include <hip/hip_runtime.h>
#include <cstdio>
#include <cstdint>
__device__ __forceinline__ int mk_lane() { int l; asm volatile("v_mbcnt_lo_u32_b32 %0, -1, 0\n\tv_mbcnt_hi_u32_b32 %0, -1, %0" : "=v"(l)); return l; }
namespace pg8 {
#define PG8_LAS __attribute__((address_space(3)))
typedef unsigned short bf16_t;
typedef short bf16x8 __attribute__((ext_vector_type(8)));
typedef float f32x4 __attribute__((ext_vector_type(4)));
typedef unsigned u32x4 __attribute__((ext_vector_type(4)));
constexpr int BM = 256, BK = 64, HALF = 128, HTB = HALF * BK * 2  , STAGE_BYTES = 8 * HTB, NXCD = 8, WGM_DEFAULT = 4;

__host__ __device__ __forceinline__ int lds_byte(int r, int c) { const int st = (r >> 4) * 2 + (c >> 5), rr = r & 15, cc = c & 31, ob = rr * 64 + cc * 2; return st * 1024 + (ob ^ (((ob >> 9) & 1) << 5)); }
__host__ __device__ __forceinline__ void stage_rc(int b, int& R, int& C) { const int st = b / 1024, sb = b % 1024, swz = sb ^ (((sb >> 9) & 1) << 5); R = (st >> 1) * 16 + swz / 64; C = (st & 1) * 32 + (swz % 64) / 2; }
__host__ __device__ __forceinline__ int perm32(int rho) { const int n = rho >> 4, i = rho & 15; return 8 * (i >> 2) + 4 * n + (i & 3); }

struct Unit { int pm, pn, idx, koff; };
struct Gemm { const bf16_t* A; const bf16_t* Bt; int M, N, K, kloop; };

struct StaticOrder {
    static constexpr bool GATHER = false;
    int nM, nN, nwg, G, c, WGM;
    __host__ __device__ void init(int M, int N, int G_, int c_, int wgm = WGM_DEFAULT) { nM = M / BM; nN = N / BM; nwg = nM * nN; G = G_; c = c_; WGM = wgm; }
    __host__ __device__ bool next(int i, Unit& u) const {
        const long L = (long)i * G + c; if (L >= nwg) return false;
        int wgid = (int)L; { const int q = nwg / NXCD, r = nwg % NXCD, xcd = wgid % NXCD, off = wgid / NXCD; wgid = (xcd < r ? xcd * (q + 1) : r * (q + 1) + (xcd - r) * q) + off; }
        const int nig = WGM * nN, gid = wgid / nig, fm = gid * WGM, gsz = (nM - fm) < WGM ? (nM - fm) : WGM;
        u.pm = fm + ((wgid % nig) % gsz); u.pn = (wgid % nig) / gsz; u.idx = i; u.koff = 0; return true;
    }
    __device__ __forceinline__ void a_ready(const Unit&) const {}
    __device__ __forceinline__ void done(const Unit&) const {}
};

__device__ __forceinline__ unsigned cvt_pk_bf16(float lo, float hi) { unsigned r; asm volatile("v_cvt_pk_bf16_f32 %0, %1, %2" : "=v"(r) : "v"(lo), "v"(hi)); return r; }
typedef float f32x2 __attribute__((ext_vector_type(2)));
typedef unsigned u32x2 __attribute__((ext_vector_type(2)));
__device__ __forceinline__ float bf_lo(unsigned u) { return __uint_as_float(u << 16); }
__device__ __forceinline__ float bf_hi(unsigned u) { return __uint_as_float(u & 0xffff0000u); }
__device__ __forceinline__ float sigmoidf_(float x) { return __builtin_amdgcn_rcpf(1.0f + __expf(-x)); }
__device__ __forceinline__ float quad_sum(float v) { v += __int_as_float(__builtin_amdgcn_ds_swizzle(__float_as_int(v), (16 << 10) | 0x1f));
    const auto rr = __builtin_amdgcn_permlane32_swap(__float_as_uint(v), __float_as_uint(v), false, false); return __uint_as_float(rr[0]) + __uint_as_float(rr[1]); }
__device__ __forceinline__ void row_scales(const PG8_LAS float* rtab, int idx, int rloc  , float (&rs)[2][4]) {
#pragma unroll
    for (int ai = 0; ai < 2; ++ai)
#pragma unroll
        for (int m = 0; m < 4; ++m) rs[ai][m] = rtab[idx * 256 + rloc + ai * HALF + m * 16];
}
template <class Sched>
__device__ __forceinline__ void build_row_scales(const Sched& S, const float* stat, PG8_LAS float* rtab, int tid) {
    Unit u; const int r = tid & 255;
    for (int i = __builtin_amdgcn_readfirstlane(tid >> 8); S.next(i, u); i += 2) { const f32x4* p = (const f32x4*)(stat + (size_t)(u.pm * BM + r) * 16); const f32x4 a = p[0], b = p[1], c = p[2], d = p[3];
        rtab[i * 256 + r] = rsqrtf((((a[0] + a[1]) + (a[2] + a[3])) + ((b[0] + b[1]) + (b[2] + b[3])) + (((c[0] + c[1]) + (c[2] + c[3])) + ((d[0] + d[1]) + (d[2] + d[3])))) * (1.0f / 1024.0f) + 1e-6f); }
    __syncthreads();
}
template <bool SCALE> struct EpiStore {
    static constexpr bool PERM = true, AFTER_DRAIN = false;
    bf16_t* O; int ldc; int nN; const PG8_LAS float* rtab; long slab;
    __device__ __forceinline__ void operator()(const f32x4 (&acc)[2][2][4][2], const Unit& u, int wr_, int wc_, int fr_, int fq_) const {
        (void)fr_; (void)fq_; const int ln_ = mk_lane(), fr = ln_ & 15, fq = ln_ >> 4, wr = wr_, wc = wc_;
        const int row0 = u.pm * BM + wr * 64 + fr; const int col0 = (u.pn % nN) * BM + wc * 32 + 8 * fq;
        float rs[2][4]; if (SCALE) row_scales(rtab, u.idx, wr * 64 + fr, rs);
#pragma unroll
        for (int ai = 0; ai < 2; ++ai)
#pragma unroll
            for (int m = 0; m < 4; ++m) { bf16_t* rowp = O + (long)u.idx * slab + (long)(row0 + ai * HALF + m * 16) * ldc + col0; const float sc = SCALE ? rs[ai][m] : 1.0f;
#pragma unroll
                for (int bj = 0; bj < 2; ++bj) { const f32x4 v0 = acc[ai][bj][m][0] * sc, v1 = acc[ai][bj][m][1] * sc;
                    u32x4 w; w.x = cvt_pk_bf16(v0[0], v0[1]); w.y = cvt_pk_bf16(v0[2], v0[3]); w.z = cvt_pk_bf16(v1[0], v1[1]); w.w = cvt_pk_bf16(v1[2], v1[3]);
                    *(u32x4*)(rowp + bj * HALF) = w; } }
    }
};
template <bool SCALE> struct EpiSwiGLU {
    static constexpr bool PERM = true, AFTER_DRAIN = false;
    bf16_t* O; int ldc; int nN; const PG8_LAS float* rtab;
    __device__ __forceinline__ void operator()(const f32x4 (&acc)[2][2][4][2], const Unit& u, int wr_, int wc_, int fr_, int fq_) const {
        (void)fr_; (void)fq_; const int ln_ = mk_lane(), fr = ln_ & 15, fq = ln_ >> 4, wr = wr_, wc = wc_;
        const int row0 = u.pm * BM + wr * 64 + fr; const int col0 = (u.pn % nN) * HALF + wc * 32 + 8 * fq;
        float rs[2][4]; if (SCALE) row_scales(rtab, u.idx, wr * 64 + fr, rs);
#pragma unroll
        for (int ai = 0; ai < 2; ++ai)
#pragma unroll
            for (int m = 0; m < 4; ++m) { bf16_t* rowp = O + (size_t)(row0 + ai * HALF + m * 16) * ldc + col0; const float sc = SCALE ? rs[ai][m] : 1.0f;
                float r[8];
#pragma unroll
                for (int n = 0; n < 2; ++n)
#pragma unroll
                    for (int i = 0; i < 4; ++i) { const float a = acc[ai][0][m][n][i] * sc, b = acc[ai][1][m][n][i] * sc; r[n * 4 + i] = a * sigmoidf_(a) * b; }
                u32x4 w; w.x = cvt_pk_bf16(r[0], r[1]); w.y = cvt_pk_bf16(r[2], r[3]); w.z = cvt_pk_bf16(r[4], r[5]); w.w = cvt_pk_bf16(r[6], r[7]);
                *(u32x4*)rowp = w; }
    }
};
template <bool STATS> struct EpiResid {
    static constexpr bool PERM = true, AFTER_DRAIN = false;
    const bf16_t* base; bf16_t* out; int ldc; float* stat;
    __device__ __forceinline__ void operator()(const f32x4 (&acc)[2][2][4][2], const Unit& u, int wr_, int wc_, int fr_, int fq_) const {
        (void)fr_; (void)fq_; const int ln_ = mk_lane(), fr = ln_ & 15, fq = ln_ >> 4, wr = wr_, wc = wc_;
        const int col0 = u.pn * BM + wc * 32 + 8 * fq;
#pragma unroll
        for (int ai = 0; ai < 2; ++ai)
#pragma unroll
            for (int m = 0; m < 4; ++m) { const int row = u.pm * BM + ai * HALF + wr * 64 + m * 16 + fr; const size_t off = (size_t)row * ldc + col0; float ss = 0.f;
#pragma unroll
                for (int bj = 0; bj < 2; ++bj) { const size_t p = off + bj * HALF; const u32x4 bw = *(const u32x4*)(base + p);
                    f32x4 o0 = acc[ai][bj][m][0], o1 = acc[ai][bj][m][1];
                    o0[0] += bf_lo(bw.x); o0[1] += bf_hi(bw.x); o0[2] += bf_lo(bw.y); o0[3] += bf_hi(bw.y); o1[0] += bf_lo(bw.z); o1[1] += bf_hi(bw.z); o1[2] += bf_lo(bw.w); o1[3] += bf_hi(bw.w);
                    u32x4 w; w.x = cvt_pk_bf16(o0[0], o0[1]); w.y = cvt_pk_bf16(o0[2], o0[3]); w.z = cvt_pk_bf16(o1[0], o1[1]); w.w = cvt_pk_bf16(o1[2], o1[3]); *(u32x4*)(out + p) = w;
                    if (STATS) ss += ((o0[0] * o0[0] + o0[1] * o0[1]) + (o0[2] * o0[2] + o0[3] * o0[3])) + ((o1[0] * o1[0] + o1[1] * o1[1]) + (o1[2] * o1[2] + o1[3] * o1[3])); }
                if (STATS) { ss = quad_sum(ss); if (fq == 0) stat[(size_t)row * 16 + 4 * u.pn + wc] = ss; } }
    }
};
struct EpiPleP {
    static constexpr bool PERM = true, AFTER_DRAIN = false;
    bf16_t* P; int ldc;
    __device__ __forceinline__ void operator()(const f32x4 (&acc)[2][2][4][2], const Unit& u, int wr_, int wc_, int fr_, int fq_) const {
        (void)fr_; (void)fq_; const int ln_ = mk_lane(), fr = ln_ & 15, fq = ln_ >> 4, wr = wr_, wc = wc_;
        const int col0 = u.pn * BM + wc * 32 + 8 * fq;
#pragma unroll
        for (int ai = 0; ai < 2; ++ai)
#pragma unroll
            for (int m = 0; m < 4; ++m) { const size_t off = (size_t)(u.pm * BM + ai * HALF + wr * 64 + m * 16 + fr) * ldc + col0;
#pragma unroll
                for (int bj = 0; bj < 2; ++bj) { const f32x4 v0 = acc[ai][bj][m][0], v1 = acc[ai][bj][m][1]; u32x4 w; w.x = cvt_pk_bf16(v0[0], v0[1]); w.y = cvt_pk_bf16(v0[2], v0[3]); w.z = cvt_pk_bf16(v1[0], v1[1]); w.w = cvt_pk_bf16(v1[2], v1[3]);
                    *(u32x4*)(P + off + bj * HALF) = w; } }
    }
};
template <bool STATS> struct EpiPleG {
    static constexpr bool PERM = true, AFTER_DRAIN = false;
    const bf16_t* base; bf16_t* out; const bf16_t* P; int ldc; const PG8_LAS float* rtab; float* stat;
    __device__ __forceinline__ void operator()(const f32x4 (&acc)[2][2][4][2], const Unit& u, int wr_, int wc_, int fr_, int fq_) const {
        (void)fr_; (void)fq_; const int ln_ = mk_lane(), fr = ln_ & 15, fq = ln_ >> 4, wr = wr_, wc = wc_;
        const int col0 = u.pn * BM + wc * 32 + 8 * fq;
        float rs[2][4]; row_scales(rtab, u.idx, wr * 64 + fr, rs);
#pragma unroll
        for (int ai = 0; ai < 2; ++ai)
#pragma unroll
            for (int m = 0; m < 4; ++m) { const int row = u.pm * BM + ai * HALF + wr * 64 + m * 16 + fr; const size_t off = (size_t)row * ldc + col0; float ss = 0.f; const float sc = rs[ai][m];
#pragma unroll
                for (int bj = 0; bj < 2; ++bj) { const size_t p = off + bj * HALF; const u32x4 bw = *(const u32x4*)(base + p); const u32x4 pw = *(const u32x4*)(P + p);
                    const f32x4 a0 = acc[ai][bj][m][0] * sc, a1 = acc[ai][bj][m][1] * sc;
                    f32x4 o0, o1; o0[0] = bf_lo(bw.x) + bf_lo(pw.x) * sigmoidf_(a0[0]); o0[1] = bf_hi(bw.x) + bf_hi(pw.x) * sigmoidf_(a0[1]); o0[2] = bf_lo(bw.y) + bf_lo(pw.y) * sigmoidf_(a0[2]); o0[3] = bf_hi(bw.y) + bf_hi(pw.y) * sigmoidf_(a0[3]);
                    o1[0] = bf_lo(bw.z) + bf_lo(pw.z) * sigmoidf_(a1[0]); o1[1] = bf_hi(bw.z) + bf_hi(pw.z) * sigmoidf_(a1[1]); o1[2] = bf_lo(bw.w) + bf_lo(pw.w) * sigmoidf_(a1[2]); o1[3] = bf_hi(bw.w) + bf_hi(pw.w) * sigmoidf_(a1[3]);
                    u32x4 w; w.x = cvt_pk_bf16(o0[0], o0[1]); w.y = cvt_pk_bf16(o0[2], o0[3]); w.z = cvt_pk_bf16(o1[0], o1[1]); w.w = cvt_pk_bf16(o1[2], o1[3]); *(u32x4*)(out + p) = w;
                    if (STATS) ss += ((o0[0] * o0[0] + o0[1] * o0[1]) + (o0[2] * o0[2] + o0[3] * o0[3])) + ((o1[0] * o1[0] + o1[1] * o1[1]) + (o1[2] * o1[2] + o1[3] * o1[3])); }
                if (STATS) { ss = quad_sum(ss); if (fq == 0) stat[(size_t)row * 16 + 4 * u.pn + wc] = ss; } }
    }
};
struct TailOrder {
    static constexpr bool GATHER = false;
    int first, ntail, G, c, kq; const PG8_LAS int* tile_e;
    __device__ void init(int Mp, int first_, int kquarter, int G_, int c_, const PG8_LAS int* te) { first = first_; ntail = Mp / BM - first_; G = G_; c = c_; kq = kquarter; tile_e = te; }
    __device__ bool next(int i, Unit& u) const { const int s = i * G + c; if (s >= ntail * 16) return false; u.pm = first + (s >> 4); u.pn = ((s >> 2) & 3) + tile_e[u.pm] * 4; u.idx = s & 3; u.koff = (s & 3) * kq; return true; }
    __device__ __forceinline__ void a_ready(const Unit&) const {}
    __device__ __forceinline__ void done(const Unit&) const {}
};
template <bool GATHER_>
struct GroupedOrderT {
    static constexpr bool GATHER = GATHER_;
    StaticOrder so; int nN; const PG8_LAS int* tile_e; const unsigned* rowtok; PG8_LAS unsigned char* gtab;
    __device__ void init(int Mp, int N, int G_, int c_, const PG8_LAS int* te, int wgm = WGM_DEFAULT) { so.init(Mp, N, G_, c_, wgm); nN = N / BM; tile_e = te; rowtok = nullptr; gtab = nullptr; }
    __device__ bool next(int i, Unit& u) const { if (!so.next(i, u)) return false; u.pn += tile_e[u.pm] * nN; return true; }
    __device__ __forceinline__ void a_ready(const Unit&) const {}
    __device__ __forceinline__ void done(const Unit&) const {}
};
typedef GroupedOrderT<false> GroupedOrder;
template <class Epi, class Sched, bool ALIGN_EPI = false, bool SP2 = false>
__device__ __forceinline__ void gemm_phase(PG8_LAS unsigned char* lds, const Gemm g, const Sched& S, const Epi& E, int wave_s) {
    int tid_ = wave_s * 64 + mk_lane(); asm volatile("" : "+v"(tid_));
    const int tid = tid_, wid = __builtin_amdgcn_readfirstlane(tid >> 6), lane = tid & 63, wr = wid >> 2, wc = wid & 3, fr = lane & 15, fq = lane >> 4;
    int K_ = g.K; asm volatile("" : "+s"(K_));
    const int K = K_;
    int kl_ = g.kloop; asm volatile("" : "+s"(kl_)); const int nt = kl_ / BK;
    unsigned voffA[2], voffB[2];
#pragma unroll
    for (int i = 0; i < 2; ++i) { int R, C; stage_rc(tid * 16 + i * 8192, R, C); const int Rb = Epi::PERM ? ((R & ~31) + perm32(R & 31)) : R;
        voffA[i] = (unsigned)(R * K + C) * 2u; voffB[i] = (unsigned)(Rb * K + C) * 2u; }
    const size_t kstep = (size_t)(BK * 2);
    const size_t hstep = (size_t)HALF * K * 2;
    const size_t tstep = 2 * hstep;
    const unsigned ldsw = (unsigned)wid * 1024u;
    static_assert(!Sched::GATHER || SP2, "the gathered A staging is written for the SP2 loop");
    unsigned vg[4] = {0u, 0u, 0u, 0u}, gr0 = 0u, gC2 = 0u; const unsigned K2 = (unsigned)K * 2u;
    if constexpr (Sched::GATHER) { int R_, C_; stage_rc(tid * 16, R_, C_); gr0 = (unsigned)R_; gC2 = (unsigned)C_ * 2u; }
    (void)vg; (void)gr0; (void)gC2; (void)K2;
    const int aoff = lds_byte(wr * 64 + fr, fq * 8), boff = lds_byte(wc * 32 + fr, fq * 8);
#define PG8_SA(b, h) (((b) * 2 + (h)) * HTB)
#define PG8_SB(b, h) ((4 + (b) * 2 + (h)) * HTB)
#define PG8_STAGE(bufoff, gbase, voff) do { _Pragma("unroll") for (int _i = 0; _i < 2; ++_i) \
        __builtin_amdgcn_global_load_lds((const unsigned*)((const char*)(gbase) + (voff)[_i]), (PG8_LAS unsigned*)(lds + (bufoff) + ldsw + _i * 8192), 16, 0, 0); } while (0)
#define PG8_STAGE_A(bufoff, gbase, h) do { if constexpr (Sched::GATHER) { _Pragma("unroll") for (int _i = 0; _i < 2; ++_i) \
        __builtin_amdgcn_global_load_lds((const unsigned*)((gbase) + vg[2 * (h) + _i]), (PG8_LAS unsigned*)(lds + (bufoff) + ldsw + _i * 8192), 16, 0, 0); } \
    else PG8_STAGE(bufoff, (gbase) + (h) * hstep, voffA); } while (0)
#define PG8_TAB_DMA(u, buf) do { if (wid == 0) __builtin_amdgcn_global_load_lds((const unsigned*)(S.rowtok + (size_t)(u).pm * 256 + lane * 4), (PG8_LAS unsigned*)(S.gtab + (buf) * 1024), 16, 0, 0); } while (0)
#define PG8_TAB_READ(buf) do { const u32x4 q_ = *(const PG8_LAS u32x4*)(S.gtab + (buf) * 1024 + gr0 * 16u); _Pragma("unroll") for (int j_ = 0; j_ < 4; ++j_) vg[j_] = q_[j_] * K2 + gC2; } while (0)
#define PG8_LDA(dst, b, h) do { _Pragma("unroll") for (int m = 0; m < 4; ++m) _Pragma("unroll") for (int k = 0; k < 2; ++k) dst[m][k] = *(const PG8_LAS bf16x8*)(lds + PG8_SA(b, h) + aoff + m * 2048 + k * 1024); } while (0)
#define PG8_LDB(dst, b, h) do { _Pragma("unroll") for (int n = 0; n < 2; ++n) _Pragma("unroll") for (int k = 0; k < 2; ++k) dst[n][k] = *(const PG8_LAS bf16x8*)(lds + PG8_SB(b, h) + boff + n * 2048 + k * 1024); } while (0)
#define PG8_MMA(ai, bj, At, Bt) do { __builtin_amdgcn_s_setprio(1); _Pragma("unroll") for (int m = 0; m < 4; ++m) _Pragma("unroll") for (int n = 0; n < 2; ++n) _Pragma("unroll") for (int k = 0; k < 2; ++k) \
        acc[ai][bj][m][n] = __builtin_amdgcn_mfma_f32_16x16x32_bf16(Bt[n][k], At[m][k], acc[ai][bj][m][n], 0, 0, 0); __builtin_amdgcn_s_setprio(0); } while (0)
#define PG8_WAIT_V(n) asm volatile("s_waitcnt vmcnt(" #n ")" ::: "memory")
#define PG8_WAIT_L(n) asm volatile("s_waitcnt lgkmcnt(" #n ")" ::: "memory")
#define PG8_BAR __builtin_amdgcn_s_barrier()
#define PG8_SCHED __builtin_amdgcn_sched_barrier(0)
    Unit cur, nxt; int ui = 0;
    if (!S.next(0, cur)) return;
    f32x4 acc[2][2][4][2];
    float zf_ = 0.f; asm volatile("" : "+v"(zf_));
#pragma unroll
    for (int a = 0; a < 2; ++a)
#pragma unroll
        for (int b = 0; b < 2; ++b)
#pragma unroll
            for (int m = 0; m < 4; ++m)
#pragma unroll
                for (int n = 0; n < 2; ++n) acc[a][b][m][n] = (f32x4){zf_, zf_, zf_, zf_};
    bf16x8 At[4][2], B0[2][2], B1[2][2];
    const char* cA = (const char*)g.A + (Sched::GATHER ? (size_t)0 : (size_t)cur.pm * tstep) + (size_t)cur.koff * 2; const char* cB = (const char*)g.Bt + (size_t)cur.pn * tstep + (size_t)cur.koff * 2;
    S.a_ready(cur);
    if constexpr (Sched::GATHER) { PG8_TAB_DMA(cur, 0); PG8_WAIT_V(0); PG8_BAR; PG8_TAB_READ(0); }
    if constexpr (SP2) {
        PG8_STAGE(PG8_SB(0, 0), cB, voffB); PG8_STAGE(PG8_SB(0, 1), cB + hstep, voffB); PG8_STAGE_A(PG8_SA(0, 0), cA, 0); PG8_STAGE_A(PG8_SA(0, 1), cA, 1);
        if (wr == 1) PG8_BAR;
        PG8_WAIT_V(2); PG8_BAR;
        PG8_STAGE(PG8_SB(1, 0), cB + kstep, voffB); PG8_STAGE_A(PG8_SA(1, 0), cA + kstep, 0); PG8_STAGE(PG8_SB(1, 1), cB + hstep + kstep, voffB);
        PG8_WAIT_V(6); PG8_BAR;
    } else {
        PG8_STAGE(PG8_SB(0, 0), cB, voffB); PG8_STAGE_A(PG8_SA(0, 0), cA, 0); PG8_STAGE(PG8_SB(0, 1), cB + hstep, voffB); PG8_STAGE_A(PG8_SA(0, 1), cA, 1);
        if (wr == 1) PG8_BAR;
        PG8_WAIT_V(4); PG8_BAR;
        PG8_STAGE(PG8_SB(1, 0), cB + kstep, voffB); PG8_STAGE_A(PG8_SA(1, 0), cA + kstep, 0); PG8_STAGE(PG8_SB(1, 1), cB + hstep + kstep, voffB);
        PG8_WAIT_V(6); PG8_BAR;
    }
    for (;;) {
        const bool has_next = S.next(ui + 1, nxt);
        const char* nA = has_next ? (const char*)g.A + (Sched::GATHER ? (size_t)0 : (size_t)nxt.pm * tstep) + (size_t)nxt.koff * 2 : cA; const char* nB = has_next ? (const char*)g.Bt + (size_t)nxt.pn * tstep + (size_t)nxt.koff * 2 : cB;
        if constexpr (Sched::GATHER) { if (has_next) PG8_TAB_DMA(nxt, (ui + 1) & 1); }
        for (int t = 0; t < nt; t += 2) {
            const bool last = (t == nt - 2);
            const char* a1 = cA + (size_t)(t + 1) * kstep;
            const char* a2 = last ? nA : cA + (size_t)(t + 2) * kstep; const char* b2 = last ? nB : cB + (size_t)(t + 2) * kstep;
            const char* a3 = a2 + kstep; const char* b3 = b2 + kstep;
            if (last && has_next) S.a_ready(nxt);
            if constexpr (SP2) {
            PG8_LDB(B0, 0, 0); PG8_LDB(B1, 0, 1); PG8_SCHED; PG8_LDA(At, 0, 0); PG8_STAGE_A(PG8_SA(1, 1), a1, 1);
            if constexpr (Sched::GATHER) { if (last && has_next) PG8_TAB_READ((ui + 1) & 1); }
            PG8_WAIT_V(8); PG8_WAIT_L(0); PG8_BAR; PG8_MMA(0, 0, At, B0); PG8_MMA(0, 1, At, B1); PG8_BAR; PG8_SCHED;
            PG8_LDA(At, 0, 1); PG8_STAGE(PG8_SB(0, 0), b2, voffB); PG8_STAGE(PG8_SB(0, 1), b2 + hstep, voffB); PG8_STAGE_A(PG8_SA(0, 0), a2, 0);
            PG8_WAIT_V(8); PG8_WAIT_L(0); PG8_BAR; PG8_MMA(1, 0, At, B0); PG8_MMA(1, 1, At, B1); PG8_BAR; PG8_SCHED;
            PG8_LDB(B0, 1, 0); PG8_LDB(B1, 1, 1); PG8_SCHED; PG8_LDA(At, 1, 0); PG8_STAGE_A(PG8_SA(0, 1), a2, 1);
            PG8_WAIT_V(8); PG8_WAIT_L(0); PG8_BAR; PG8_MMA(0, 0, At, B0); PG8_MMA(0, 1, At, B1); PG8_BAR; PG8_SCHED;
            PG8_LDA(At, 1, 1); PG8_STAGE(PG8_SB(1, 0), b3, voffB); PG8_STAGE(PG8_SB(1, 1), b3 + hstep, voffB); PG8_STAGE_A(PG8_SA(1, 0), a3, 0);
            PG8_WAIT_V(8); PG8_WAIT_L(0); PG8_BAR; PG8_MMA(1, 0, At, B0); PG8_MMA(1, 1, At, B1); PG8_BAR; PG8_SCHED;
            } else {
            PG8_LDB(B0, 0, 0); PG8_SCHED; PG8_LDA(At, 0, 0); PG8_STAGE_A(PG8_SA(1, 1), a1, 1);
            PG8_WAIT_L(8); PG8_BAR; PG8_WAIT_L(0); PG8_MMA(0, 0, At, B0); PG8_BAR; PG8_SCHED;
            PG8_LDB(B1, 0, 1); PG8_STAGE(PG8_SB(0, 0), b2, voffB);
            PG8_BAR; PG8_WAIT_L(0); PG8_MMA(0, 1, At, B1); PG8_BAR;
            PG8_LDA(At, 0, 1); PG8_STAGE_A(PG8_SA(0, 0), a2, 0);
            PG8_BAR; PG8_WAIT_L(0); PG8_MMA(1, 0, At, B0); PG8_BAR; PG8_SCHED;
            PG8_STAGE(PG8_SB(0, 1), b2 + hstep, voffB);
            PG8_WAIT_V(6); PG8_BAR; PG8_MMA(1, 1, At, B1); PG8_BAR;
            PG8_LDB(B0, 1, 0); PG8_SCHED; PG8_LDA(At, 1, 0); PG8_STAGE_A(PG8_SA(0, 1), a2, 1);
            PG8_WAIT_L(8); PG8_BAR; PG8_WAIT_L(0); PG8_MMA(0, 0, At, B0); PG8_BAR; PG8_SCHED;
            PG8_LDB(B1, 1, 1); PG8_STAGE(PG8_SB(1, 0), b3, voffB);
            PG8_BAR; PG8_WAIT_L(0); PG8_MMA(0, 1, At, B1); PG8_BAR;
            PG8_LDA(At, 1, 1); PG8_STAGE_A(PG8_SA(1, 0), a3, 0);
            PG8_BAR; PG8_WAIT_L(0); PG8_MMA(1, 0, At, B0); PG8_BAR; PG8_SCHED;
            PG8_STAGE(PG8_SB(1, 1), b3 + hstep, voffB);
            PG8_WAIT_V(6); PG8_BAR; PG8_MMA(1, 1, At, B1); PG8_BAR;
            }
        }
        if constexpr (ALIGN_EPI) { if (wr == 0) PG8_BAR; }
        if constexpr (!Epi::AFTER_DRAIN) { E(acc, cur, wr, wc, fr, fq); S.done(cur); }
        if (!has_next) break;
        zf_ = 0.f; asm volatile("" : "+v"(zf_));
#pragma unroll
        for (int a = 0; a < 2; ++a)
#pragma unroll
            for (int b = 0; b < 2; ++b)
#pragma unroll
                for (int m = 0; m < 4; ++m)
#pragma unroll
                    for (int n = 0; n < 2; ++n) acc[a][b][m][n] = (f32x4){zf_, zf_, zf_, zf_};
        cur = nxt; cA = nA; cB = nB; ++ui;
        if constexpr (ALIGN_EPI) { if (wr == 1) PG8_BAR; }
    }
    PG8_WAIT_V(0);
    if constexpr (!ALIGN_EPI) { if (wr == 0) PG8_BAR; }
    PG8_BAR;
    if constexpr (Epi::AFTER_DRAIN) { E.fused(acc, cur, wr, wc, fr, fq, lds, wid, lane); S.done(cur); }
#undef PG8_SA
#undef PG8_SB
#undef PG8_STAGE
#undef PG8_STAGE_A
#undef PG8_TAB_DMA
#undef PG8_TAB_READ
#undef PG8_LDA
#undef PG8_LDB
#undef PG8_MMA
#undef PG8_WAIT_V
#undef PG8_WAIT_L
#undef PG8_BAR
#undef PG8_SCHED
}
}
constexpr int NWAVES = 8, NTHR = NWAVES * 64;
constexpr int NB = 8, SEQ = 4096, T = NB * SEQ, D = 1024, DEPTH = 4;
constexpr int DIN = 3468, DINP = 3584;
constexpr int C_GQ = 0, C_GK = 384, C_GV = 768, C_GZ = 1152, C_DQ = 1536, C_DK = 1920, C_DV = 2304, C_SQ = 2688, C_SK = 2944, C_SV = 3200, C_GA = 3456, C_GB = 3462;
constexpr int DFF = 2816, MFF = 3584, NE = 8, PLE = 256;
constexpr int MROWS = 2 * T + 2048;
constexpr float EPS = 1e-6f;
constexpr size_t MiB = 1u << 20;
constexpr size_t WS_CTL = 0, CTL_ZERO_BYTES = 1 * MiB;
constexpr size_t WS_WIN = 1 * MiB;
constexpr size_t WS_WOUT = 29 * MiB;
constexpr size_t WS_WGATE = 37 * MiB;
constexpr size_t WS_WPROJ = 45 * MiB;
constexpr size_t WS_WF13 = 47 * MiB;
constexpr size_t WS_WF2 = 69 * MiB;
constexpr size_t WS_WM13 = 80 * MiB;
constexpr size_t WS_WM2 = 304 * MiB;
constexpr size_t WS_HN = 416 * MiB;
constexpr size_t WS_U = 480 * MiB;
constexpr size_t WS_PROJ = WS_U;
constexpr size_t WS_OMIX = WS_U + 224 * MiB;
constexpr size_t WS_GDN = WS_U + 288 * MiB;
constexpr size_t WS_DSW = WS_U + 448 * MiB;
constexpr size_t WS_ACT = WS_U;
constexpr size_t WS_ASORT = WS_U;
constexpr size_t WS_MACT = WS_U + 132 * MiB;
constexpr size_t WS_POUT = WS_U + 132 * MiB;
constexpr size_t WS_PB = WS_U + 196 * MiB;
constexpr size_t WS_ROUTE = 1074 * MiB;
constexpr size_t WS_STATA = 1075 * MiB;
constexpr size_t WS_STATB = 1077 * MiB;
constexpr size_t WS_END = 1079 * MiB;
static_assert(WS_MACT + (size_t)MROWS * MFF * 2 <= WS_ROUTE && WS_ASORT + (size_t)MROWS * D * 2 <= WS_MACT, "d_ws map");
constexpr int CW_BAR = 4096;
constexpr int RING_OFF = 0, RING_BYTES = 131072;
constexpr int LDSCTL_OFF = RING_BYTES, MISC_OFF = LDSCTL_OFF + 320;
constexpr int TILEE_OFF = LDSCTL_OFF + 1024;
constexpr int RTAB_OFF = LDSCTL_OFF + 4096;
constexpr int LDS_BYTES = 147456;
#define GAS __attribute__((address_space(1)))
#define LAS __attribute__((address_space(3)))
typedef unsigned short bf16;
typedef unsigned v4u __attribute__((ext_vector_type(4)));
typedef float f32x4 __attribute__((ext_vector_type(4)));
typedef short bf16x8 __attribute__((ext_vector_type(8)));
typedef GAS unsigned gu32;
typedef GAS unsigned long long gu64;
#define RLX_AGENT __ATOMIC_RELAXED, __HIP_MEMORY_SCOPE_AGENT
#define LDS_WAIT() asm volatile("s_waitcnt lgkmcnt(0)" ::: "memory")
#define VM_WAIT() asm volatile("s_waitcnt vmcnt(0)" ::: "memory")
__device__ __forceinline__ unsigned long long rt() { return __builtin_amdgcn_s_memrealtime(); }
__device__ __forceinline__ unsigned f2bf(float f) { unsigned u = __builtin_bit_cast(unsigned, f); return (u + 0x7fffu + ((u >> 16) & 1u)) >> 16; }
__device__ __forceinline__ unsigned pk2(float lo, float hi) { return f2bf(lo) | (f2bf(hi) << 16); }

#define XB_TMO      128
#define XB_XCNT(j)  (256  + 64 * (j))
#define XB_XSUB(j)  (1280 + 64 * (j))
#define XB_XGEN(j)  (2304 + 64 * (j))
#define XB_TOP      3328
#define XB_TOPGEN   3392
#define XCD_BAR_WORDS 3456
#define XB_SPIN_CAP (1u << 22)

__device__ __forceinline__ unsigned xb_ld(unsigned* p)              { return __hip_atomic_load(p, __ATOMIC_RELAXED, __HIP_MEMORY_SCOPE_AGENT); }
__device__ __forceinline__ unsigned xb_add(unsigned* p, unsigned v) { return __hip_atomic_fetch_add(p, v, __ATOMIC_RELAXED, __HIP_MEMORY_SCOPE_AGENT); }
__device__ __forceinline__ unsigned xb_xcc_id() { return (unsigned)__builtin_amdgcn_s_getreg((3 << 11) | 20) & 0xFu; }
#define XB_SPIN(cond, bar) do { unsigned _sp = 0; while (cond) { __builtin_amdgcn_s_sleep(1); \
    if ((++_sp & 255u) == 0u) { if (xb_ld(&(bar)[XB_TMO])) break; if (_sp > XB_SPIN_CAP) { atomicAdd(&(bar)[XB_TMO], 1u); break; } } } } while (0)

struct XcdBarrier {
    unsigned* bar; unsigned x;
    volatile LAS unsigned* st;
};

__device__ __forceinline__ XcdBarrier xcd_barrier_post(unsigned* bar, volatile LAS unsigned* st) {
    XcdBarrier b; b.bar = bar; b.x = xb_xcc_id(); b.st = st;
    if (threadIdx.x == 0) (void)xb_add(&bar[XB_XCNT(b.x)], 1u);
    return b;
}
__device__ __forceinline__ void xcd_barrier_complete(unsigned* bar, unsigned x, unsigned& nloc, unsigned& nx) {
    const unsigned G = gridDim.x * gridDim.y * gridDim.z;
    unsigned sum, cnt, mine, sp = 0u;
    for (;;) {
        sum = 0u; cnt = 0u; mine = 0u;
#pragma unroll
        for (unsigned j = 0; j < 16; ++j) { const unsigned c = xb_ld(&bar[XB_XCNT(j)]); sum += c; cnt += (c > 0u) ? 1u : 0u; mine = (j == x) ? c : mine; }
        if (sum == G) break;
        __builtin_amdgcn_s_sleep(1);
        if ((++sp & 255u) == 0u) { if (xb_ld(&bar[XB_TMO])) break; if (sp > XB_SPIN_CAP) { atomicAdd(&bar[XB_TMO], 1u); break; } }
    }
    nloc = mine > 0u ? mine : 1u; nx = cnt > 0u ? cnt : 1u;
}

__device__ __forceinline__ void xcd_barrier(const XcdBarrier& b) {
    asm volatile("s_waitcnt vmcnt(0)" ::: "memory");
    __syncthreads();
    if (threadIdx.x == 0) {
        unsigned* bar = b.bar;
        __builtin_amdgcn_s_waitcnt(0);
        unsigned nloc = b.st[0], nx = b.st[1];
        if (nloc == 0u) { xcd_barrier_complete(bar, b.x, nloc, nx); b.st[0] = nloc; b.st[1] = nx; }
        const unsigned old = xb_add(&bar[XB_XSUB(b.x)], 1u);
        const unsigned gen = old / nloc;
        if (old + 1u == (gen + 1u) * nloc) {
            __builtin_amdgcn_fence(__ATOMIC_RELEASE, "agent");
            asm volatile("s_waitcnt vmcnt(0)" ::: "memory");
            const unsigned og = xb_add(&bar[XB_TOP], 1u);
            const unsigned tg = og / nx;
            if (og + 1u == (tg + 1u) * nx) xb_add(&bar[XB_TOPGEN], 1u);
            else XB_SPIN(xb_ld(&bar[XB_TOPGEN]) == tg, bar);
            __builtin_amdgcn_fence(__ATOMIC_ACQUIRE, "agent");
            xb_add(&bar[XB_XGEN(b.x)], 1u);
            asm volatile("s_waitcnt vmcnt(0)" ::: "memory");
        } else {
            { const unsigned ai = old - gen * nloc + 1u;
              if (ai == nloc / 2u || ai == (3u * nloc) / 4u) asm volatile("buffer_wbl2 sc1" ::: "memory"); }
            XB_SPIN(xb_ld(&bar[XB_XGEN(b.x)]) == gen, bar);
            __builtin_amdgcn_fence(__ATOMIC_ACQUIRE, "agent");
            asm volatile("s_waitcnt vmcnt(0)" ::: "memory");
        }
    }
    __syncthreads();
}
typedef unsigned u32x2 __attribute__((ext_vector_type(2)));
__device__ __forceinline__ float bf2f(bf16 u) { return __uint_as_float((unsigned)u << 16); }
__device__ __forceinline__ float bflo(unsigned u) { return __uint_as_float(u << 16); }
__device__ __forceinline__ float bfhi(unsigned u) { return __uint_as_float(u & 0xffff0000u); }
#define SWZ_XOR(v, k) __int_as_float(__builtin_amdgcn_ds_swizzle(__float_as_int(v), ((k) << 10) | 0x1f))
__device__ __forceinline__ float wave_sum(float v) {
    v += SWZ_XOR(v, 1); v += SWZ_XOR(v, 2); v += SWZ_XOR(v, 4); v += SWZ_XOR(v, 8); v += SWZ_XOR(v, 16);
    const auto rr = __builtin_amdgcn_permlane32_swap(__float_as_uint(v), __float_as_uint(v), false, false);
    return __uint_as_float(rr[0]) + __uint_as_float(rr[1]);
}
__device__ __forceinline__ float wave_max(float v) {
    v = fmaxf(v, SWZ_XOR(v, 1)); v = fmaxf(v, SWZ_XOR(v, 2)); v = fmaxf(v, SWZ_XOR(v, 4)); v = fmaxf(v, SWZ_XOR(v, 8)); v = fmaxf(v, SWZ_XOR(v, 16));
    const auto rr = __builtin_amdgcn_permlane32_swap(__float_as_uint(v), __float_as_uint(v), false, false);
    return fmaxf(__uint_as_float(rr[0]), __uint_as_float(rr[1]));
}
__device__ __forceinline__ float silu_f(float x) { return x * __builtin_amdgcn_rcpf(1.0f + __expf(-x)); }
__device__ __forceinline__ float sigm_f(float x) { return __builtin_amdgcn_rcpf(1.0f + __expf(-x)); }
__device__ __forceinline__ float softplus_f(float x) { const float e = __expf(-fabsf(x));
    const float l = e < 0.02f ? e * (1.0f - e * (0.5f - e * (0.33333334f - 0.25f * e))) : __logf(1.0f + e); return fmaxf(x, 0.f) + l; }
__device__ __forceinline__ float rdlane(float v, int l) { return __int_as_float(__builtin_amdgcn_readlane(__float_as_int(v), l)); }

#define CAS __attribute__((address_space(4)))
struct Args { const float* in[23]; float* out; unsigned char* ws; };

struct MapIn { const float* W; const float* nw;
    __device__ __forceinline__ float operator()(int k, int n) const { const int o = n < 1536 ? n : (n < 3456 ? n + 12 : (n < 3468 ? 1536 + (n - 3456) : -1)); return o >= 0 ? W[(size_t)k * DIN + o] * nw[k] : 0.f; } };
struct MapPlain { const float* W; int N;
    __device__ __forceinline__ float operator()(int k, int n) const { return W[(size_t)k * N + n]; } };
struct MapScaled { const float* W; int N; const float* nw;
    __device__ __forceinline__ float operator()(int k, int n) const { return W[(size_t)k * N + n] * nw[k]; } };
template <class Map>
__device__ __forceinline__ void tr_item(const Map& map, int K, bf16* WT, LAS float* scr, int kb, int nb, int lane, int drow0 = -1) {
    const int k0 = 64 * kb, n0 = 32 * nb; const int d0 = drow0 < 0 ? n0 : drow0;
#pragma unroll 8
    for (int i = 0; i < 32; ++i) { const int kk = 2 * i + (lane >> 5); scr[kk * 33 + (lane & 31)] = map(k0 + kk, n0 + (lane & 31)); }
    LDS_WAIT(); asm volatile("" ::: "memory");
    const int c = lane & 7;
#pragma unroll
    for (int j = 0; j < 4; ++j) { const int n = (lane >> 3) + 8 * j; const LAS float* s = scr + (8 * c) * 33 + n;
        v4u o; o.x = pk2(s[0 * 33], s[1 * 33]); o.y = pk2(s[2 * 33], s[3 * 33]); o.z = pk2(s[4 * 33], s[5 * 33]); o.w = pk2(s[6 * 33], s[7 * 33]);
        *(GAS v4u*)(WT + (size_t)(d0 + n) * K + k0 + 8 * c) = o; }
    LDS_WAIT(); asm volatile("" ::: "memory");
}
__device__ __forceinline__ void prologue_phase(const CAS Args* a, LAS unsigned char* lds, int gw, int NGW, int wave, int lane) {
    LAS float* scr = (LAS float*)(lds + RING_OFF + wave * 16384);
    constexpr int I_IN = 16 * (DINP / 32), I_OUT = 16 * 32, I_GATE = 16 * 32, I_PROJ = 4 * 32, I_L = I_IN + I_OUT + I_GATE + I_PROJ;
    constexpr int I_F13 = 16 * (2 * DFF / 32), I_F2 = (DFF / 64) * 32, I_F = I_F13 + I_F2;
    constexpr int I_M13 = 16 * (2 * MFF / 32), I_M2 = (MFF / 64) * 32, I_M = I_M13 + I_M2;
    constexpr int NITEMS = 4 * I_L + 2 * I_F + 16 * I_M;
    unsigned char* ws = (unsigned char*)a->ws;
    for (int it0 = gw; it0 < NITEMS; it0 += NGW) {
        int it = it0;
        if (it < 4 * I_L) { const int l = it / I_L; int r = it % I_L;
            if (r < I_IN) { MapIn m{a->in[3] + (size_t)l * D * DIN, a->in[2] + l * D}; tr_item(m, D, (bf16*)(ws + WS_WIN) + (size_t)l * DINP * D, scr, r / (DINP / 32), r % (DINP / 32), lane); continue; } r -= I_IN;
            if (r < I_OUT) { MapPlain m{a->in[10] + (size_t)l * D * D, D}; tr_item(m, D, (bf16*)(ws + WS_WOUT) + (size_t)l * D * D, scr, r / 32, r % 32, lane); continue; } r -= I_OUT;
            if (r < I_GATE) { MapScaled m{a->in[21] + (size_t)l * D * D, D, a->in[20] + l * D}; tr_item(m, D, (bf16*)(ws + WS_WGATE) + (size_t)l * D * D, scr, r / 32, r % 32, lane); continue; } r -= I_GATE;
            { MapPlain m{a->in[19] + (size_t)l * PLE * D, D}; tr_item(m, PLE, (bf16*)(ws + WS_WPROJ) + (size_t)l * D * PLE, scr, r / 32, r % 32, lane); continue; }
        }
        it -= 4 * I_L;
        if (it < 2 * I_F) { const int j = it / I_F; int r = it % I_F;
            if (r < I_F13) { const int half = r / (I_F13 / 2), rr = r % (I_F13 / 2), kb = rr / (DFF / 32), nb = rr % (DFF / 32);
                MapScaled m{a->in[12 + half] + (size_t)j * D * DFF, DFF, a->in[11] + 2 * j * D}; tr_item(m, D, (bf16*)(ws + WS_WF13) + (size_t)j * 2 * DFF * D, scr, kb, nb, lane, ((32 * nb) >> 7) * 256 + ((32 * nb) & 127) + 128 * half); continue; } r -= I_F13;
            { MapPlain m{a->in[14] + (size_t)j * DFF * D, D}; tr_item(m, DFF, (bf16*)(ws + WS_WF2) + (size_t)j * D * DFF, scr, r / 32, r % 32, lane); continue; }
        }
        it -= 2 * I_F;
        { const int je = it / I_M; int r = it % I_M;
            if (r < I_M13) { const int half = r / (I_M13 / 2), rr = r % (I_M13 / 2), kb = rr / (MFF / 32), nb = rr % (MFF / 32);
                MapPlain m{a->in[16 + half] + (size_t)je * D * MFF, MFF}; tr_item(m, D, (bf16*)(ws + WS_WM13) + (size_t)je * 2 * MFF * D, scr, kb, nb, lane, ((32 * nb) >> 7) * 256 + ((32 * nb) & 127) + 128 * half); continue; } r -= I_M13;
            { MapPlain m{a->in[18] + (size_t)je * MFF * D, D}; tr_item(m, MFF, (bf16*)(ws + WS_WM2) + (size_t)je * D * MFF, scr, r / 32, r % 32, lane); }
        }
    }
}

__device__ __forceinline__ void norm_phase(const void* hin, bool in_f32, const float* w, bf16* hn, float* outf, int mode,
                                           const bf16* ysort, const bf16* ypart, const int* pos, const float* gate, float* stat,
                                           bool do_route, const LAS float* rlds, int* tok_e, float* tok_g,
                                           int gw, int NGW, int lane) {
    f32x4 wv[4];
#pragma unroll
    for (int j = 0; j < 4; ++j) wv[j] = *(const f32x4*)(w + 4 * lane + 256 * j);
    for (int m = gw; m < T; m += NGW) {
        f32x4 v[4];
        if (in_f32) { const float* xr = (const float*)hin + (size_t)m * D + 4 * lane;
#pragma unroll
            for (int j = 0; j < 4; ++j) v[j] = *(const f32x4*)(xr + 256 * j); }
        else { const bf16* xr = (const bf16*)hin + (size_t)m * D + 4 * lane;
#pragma unroll
            for (int j = 0; j < 4; ++j) { const u32x2 a = *(const u32x2*)(xr + 256 * j); v[j] = (f32x4){bflo(a.x), bfhi(a.x), bflo(a.y), bfhi(a.y)}; } }
        if (ysort) {
            const int p1 = pos[2 * m], p2 = pos[2 * m + 1]; const float g1 = gate[2 * m], g2 = gate[2 * m + 1];
#pragma unroll
            for (int c2 = 0; c2 < 2; ++c2) { const int p = c2 ? p2 : p1; const float g = c2 ? g2 : g1;
                if (p < 2 * T) { const bf16* y = ysort + (size_t)p * D + 4 * lane;
#pragma unroll
                    for (int j = 0; j < 4; ++j) { const u32x2 a = *(const u32x2*)(y + 256 * j); v[j][0] += g * bflo(a.x); v[j][1] += g * bfhi(a.x); v[j][2] += g * bflo(a.y); v[j][3] += g * bfhi(a.y); } }
                else {
#pragma unroll
                    for (int ks = 0; ks < 4; ++ks) { const bf16* y = ypart + ((size_t)ks * 2048 + (p - 2 * T)) * D + 4 * lane;
#pragma unroll
                        for (int j = 0; j < 4; ++j) { const u32x2 a = *(const u32x2*)(y + 256 * j); v[j][0] += g * bflo(a.x); v[j][1] += g * bfhi(a.x); v[j][2] += g * bflo(a.y); v[j][3] += g * bfhi(a.y); } } } }
        }
        float s = 0.f;
#pragma unroll
        for (int j = 0; j < 4; ++j) s += (v[j][0] * v[j][0] + v[j][1] * v[j][1]) + (v[j][2] * v[j][2] + v[j][3] * v[j][3]);
        const float ssum = wave_sum(s); const float r = mode == 1 ? 1.0f : rsqrtf(ssum * (1.0f / D) + EPS);
        if (mode == 1) { if (lane < 16) stat[(size_t)m * 16 + lane] = lane == 0 ? ssum : 0.f; }
#pragma unroll
        for (int j = 0; j < 4; ++j) if (mode != 1) v[j] = v[j] * r * wv[j];
        if (mode == 2) { float* orow = outf + (size_t)m * D + 4 * lane;
#pragma unroll
            for (int j = 0; j < 4; ++j) *(f32x4*)(orow + 256 * j) = v[j]; }
        else { bf16* orow = hn + (size_t)m * D + 4 * lane;
#pragma unroll
            for (int j = 0; j < 4; ++j) { u32x2 o; o.x = pk2(v[j][0], v[j][1]); o.y = pk2(v[j][2], v[j][3]); *(u32x2*)(orow + 256 * j) = o; } }
        if (do_route) {
            float lg[8];
#pragma unroll
            for (int e = 0; e < 8; ++e) lg[e] = 0.f;
#pragma unroll
            for (int j = 0; j < 4; ++j)
#pragma unroll
                for (int i = 0; i < 4; ++i) { const LAS f32x4* rp = (const LAS f32x4*)(rlds + (size_t)(4 * lane + 256 * j + i) * 8); const f32x4 r0 = rp[0], r1 = rp[1]; const float y = v[j][i];
                    lg[0] += y * r0[0]; lg[1] += y * r0[1]; lg[2] += y * r0[2]; lg[3] += y * r0[3]; lg[4] += y * r1[0]; lg[5] += y * r1[1]; lg[6] += y * r1[2]; lg[7] += y * r1[3]; }
#pragma unroll
            for (int e = 0; e < 8; ++e) lg[e] = wave_sum(lg[e]);
            int i1 = 0; float v1 = lg[0];
#pragma unroll
            for (int e = 1; e < 8; ++e) if (lg[e] > v1) { v1 = lg[e]; i1 = e; }
            int i2 = -1; float v2 = -3.0e38f;
#pragma unroll
            for (int e = 0; e < 8; ++e) if (e != i1 && lg[e] > v2) { v2 = lg[e]; i2 = e; }
            const float g1 = 1.0f / (1.0f + __expf(v2 - v1));
            if (lane == 0) { tok_e[m] = i1 | (i2 << 8); tok_g[2 * m] = g1; tok_g[2 * m + 1] = 1.0f - g1; }
        }
    }
}

__device__ __forceinline__ void moe_gather_phase(const int* tok_e, int* pos, const bf16* hn, bf16* asort, LAS unsigned char* lds, int gw, int NGW, int wave, int lane, int tid) {
    typedef unsigned long long u64;
    LAS u64* sc = (LAS u64*)(lds + RING_OFF);
    LAS int* tab = (LAS int*)(lds + TILEE_OFF);
    { const v4u* tp = (const v4u*)(tok_e + tid * 64); u64 lo = 0ull, hi = 0ull;
#pragma unroll 4
      for (int i = 0; i < 16; ++i) { const v4u q = tp[i]; const unsigned ev[4] = {q.x, q.y, q.z, q.w};
#pragma unroll
          for (int k = 0; k < 4; ++k) { const unsigned e1 = ev[k] & 7u, e2 = (ev[k] >> 8) & 7u;
              lo += (e1 < 4u ? 1ull << (16u * e1) : 0ull) + (e2 < 4u ? 1ull << (16u * e2) : 0ull); hi += (e1 >= 4u ? 1ull << (16u * (e1 - 4u)) : 0ull) + (e2 >= 4u ? 1ull << (16u * (e2 - 4u)) : 0ull); } }
      sc[2 * tid] = lo; sc[2 * tid + 1] = hi; }
    __syncthreads();
    for (int off = 1; off < 512; off <<= 1) {
        u64 a = 0ull, b = 0ull; if (tid >= off) { a = sc[2 * (tid - off)]; b = sc[2 * (tid - off) + 1]; }
        __syncthreads();
        if (tid >= off) { sc[2 * tid] += a; sc[2 * tid + 1] += b; }
        __syncthreads(); }
    if (tid == 0) { const u64 tl = sc[2 * 511], th = sc[2 * 511 + 1]; int off = 0;
        for (int e = 0; e < 8; ++e) { const int tot = (int)(((e < 4 ? tl : th) >> (16 * (e & 3))) & 0xffffull); tab[320 + e] = tot; tab[304 + e] = off; const int np = (tot + 255) >> 8; for (int i = 0; i < np; ++i) ((volatile LAS int*)tab)[(off >> 8) + i] = e; off += np << 8; }
        tab[312] = off; tab[300] = off; }
    __syncthreads();
    for (int u = gw; u < 2048; u += NGW) { const int g = u >> 2, c = (u >> 1) & 1, hf = u & 1; const int t = g * 64 + lane; const int ev = tok_e[t]; const int e1 = ev & 7, e2 = (ev >> 8) & 7; const int em = c ? e2 : e1;
        int rank = 0; const unsigned long long lt = (1ull << lane) - 1ull;
#pragma unroll
        for (int e = 0; e < 8; ++e) { const unsigned long long mk = __ballot(e1 == e || e2 == e); if (em == e) rank = __popcll(mk & lt); }
        int pre = 0; if (g > 0) { const u64 w = sc[2 * (g - 1) + (em >> 2)]; pre = (int)((w >> (16 * (em & 3))) & 0xffffull); }
        const int slot = tab[304 + em] + pre + rank;
        if (hf == 0) pos[2 * t + c] = slot;
        for (int i0 = 32 * hf; i0 < 32 * hf + 32; i0 += 8) {
            v4u x0[8], x1[8];
#pragma unroll
            for (int i = 0; i < 8; ++i) { const v4u* src = (const v4u*)(hn + (size_t)(g * 64 + i0 + i) * D); x0[i] = src[lane]; x1[i] = src[64 + lane]; }
#pragma unroll
            for (int i = 0; i < 8; ++i) { const int dst = __builtin_amdgcn_readlane(slot, i0 + i); v4u* d = (v4u*)(asort + (size_t)dst * D); d[lane] = x0[i]; d[64 + lane] = x1[i]; } } }
    for (int e = 0; e < 8; ++e) { const int r0 = tab[304 + e] + tab[320 + e], r1 = tab[305 + e];
        for (int r = r0 + gw; r < r1; r += NGW) { v4u* d = (v4u*)(asort + (size_t)r * D); unsigned z0 = 0u; asm volatile("" : "+v"(z0)); const v4u z = {z0, z0, z0, z0}; d[lane] = z; d[64 + lane] = z; } }
}
__device__ __forceinline__ void moe_slot_phase(const int* tok_e, int* pos, unsigned* rowtok, LAS unsigned char* lds, int gw, int NGW, int wave, int lane, int tid) {
    typedef unsigned long long u64;
    LAS u64* sc = (LAS u64*)(lds + RING_OFF);
    LAS int* tab = (LAS int*)(lds + TILEE_OFF);
    { const v4u* tp = (const v4u*)(tok_e + tid * 64); u64 lo = 0ull, hi = 0ull;
#pragma unroll 4
      for (int i = 0; i < 16; ++i) { const v4u q = tp[i]; const unsigned ev[4] = {q.x, q.y, q.z, q.w};
#pragma unroll
          for (int k = 0; k < 4; ++k) { const unsigned e1 = ev[k] & 7u, e2 = (ev[k] >> 8) & 7u;
              lo += (e1 < 4u ? 1ull << (16u * e1) : 0ull) + (e2 < 4u ? 1ull << (16u * e2) : 0ull); hi += (e1 >= 4u ? 1ull << (16u * (e1 - 4u)) : 0ull) + (e2 >= 4u ? 1ull << (16u * (e2 - 4u)) : 0ull); } }
      sc[2 * tid] = lo; sc[2 * tid + 1] = hi; }
    __syncthreads();
    for (int off = 1; off < 512; off <<= 1) {
        u64 a = 0ull, b = 0ull; if (tid >= off) { a = sc[2 * (tid - off)]; b = sc[2 * (tid - off) + 1]; }
        __syncthreads();
        if (tid >= off) { sc[2 * tid] += a; sc[2 * tid + 1] += b; }
        __syncthreads(); }
    if (tid == 0) { const u64 tl = sc[2 * 511], th = sc[2 * 511 + 1]; int off = 0;
        for (int e = 0; e < 8; ++e) { const int tot = (int)(((e < 4 ? tl : th) >> (16 * (e & 3))) & 0xffffull); tab[320 + e] = tot; tab[304 + e] = off; const int np = (tot + 255) >> 8; for (int i = 0; i < np; ++i) ((volatile LAS int*)tab)[(off >> 8) + i] = e; off += np << 8; }
        tab[312] = off; tab[300] = off; }
    __syncthreads();
    for (int u = gw; u < 1024; u += NGW) { const int g = u >> 1, c = u & 1; const int t = g * 64 + lane; const int ev = tok_e[t]; const int e1 = ev & 7, e2 = (ev >> 8) & 7; const int em = c ? e2 : e1;
        int rank = 0; const unsigned long long lt = (1ull << lane) - 1ull;
#pragma unroll
        for (int e = 0; e < 8; ++e) { const unsigned long long mk = __ballot(e1 == e || e2 == e); if (em == e) rank = __popcll(mk & lt); }
        int pre = 0; if (g > 0) { const u64 w = sc[2 * (g - 1) + (em >> 2)]; pre = (int)((w >> (16 * (em & 3))) & 0xffffull); }
        const int slot = tab[304 + em] + pre + rank;
        pos[2 * t + c] = slot;
        rowtok[(slot & ~255) + ((slot & 63) << 2) + ((slot >> 6) & 3)] = (unsigned)t; }
    for (int e = 0; e < 8; ++e) { const int r0 = tab[304 + e] + tab[320 + e], r1 = tab[305 + e];
        for (int r = r0 + gw * 64 + lane; r < r1; r += NGW * 64) rowtok[(r & ~255) + ((r & 63) << 2) + ((r >> 6) & 3)] = 0u; }
}
typedef float f32x16 __attribute__((ext_vector_type(16)));
typedef short v4i16_t __attribute__((ext_vector_type(4)));
__device__ __forceinline__ int crow(int r, int hi) { return (r & 3) + 8 * (r >> 2) + 4 * hi; }
typedef float f32x2_t __attribute__((ext_vector_type(2))); typedef __bf16 bf16x2_t __attribute__((ext_vector_type(2)));
__device__ __forceinline__ unsigned cvtpk(float lo, float hi) { const f32x2_t v = {lo, hi}; const bf16x2_t b = __builtin_convertvector(v, bf16x2_t); return __builtin_bit_cast(unsigned, b); }
__device__ __forceinline__ bf16x8 mk8(unsigned a, unsigned b, unsigned c, unsigned d) { const v4u w = {a, b, c, d}; return __builtin_bit_cast(bf16x8, w); }
__device__ __forceinline__ bf16x8 pack8(const float* x) { return mk8(cvtpk(x[0], x[1]), cvtpk(x[2], x[3]), cvtpk(x[4], x[5]), cvtpk(x[6], x[7])); }
__device__ __forceinline__ bf16x8 tr_frag(const LAS unsigned char* tile, int stride, int row0, int col0, int lane) {
    const LAS unsigned char* p = tile + (row0 + ((lane & 15) >> 2)) * stride + (col0 + 4 * (lane & 3)) * 2;
    const v4i16_t a = __builtin_amdgcn_ds_read_tr16_b64_v4i16((LAS v4i16_t*)p);
    const v4i16_t b = __builtin_amdgcn_ds_read_tr16_b64_v4i16((LAS v4i16_t*)(p + 8 * stride));
    return (bf16x8){a[0], a[1], a[2], a[3], b[0], b[1], b[2], b[3]};
}
__device__ __forceinline__ float half_bcast_lo(float x) { const auto rr = __builtin_amdgcn_permlane32_swap(__float_as_uint(x), __float_as_uint(x), false, false); return __uint_as_float(rr[0]); }
__device__ __forceinline__ float half_sum(float x) { const auto rr = __builtin_amdgcn_permlane32_swap(__float_as_uint(x), __float_as_uint(x), false, false); return __uint_as_float(rr[0]) + __uint_as_float(rr[1]); }
__device__ __forceinline__ float half_max(float x) { const auto rr = __builtin_amdgcn_permlane32_swap(__float_as_uint(x), __float_as_uint(x), false, false); return fmaxf(__uint_as_float(rr[0]), __uint_as_float(rr[1])); }

constexpr int SB_STRIDE = 144, SB_WBYTES = 2 * 32 * SB_STRIDE;
constexpr float SB_EXIT = 48.0f;
__device__ __forceinline__ void sb_wave_unit(int u, int layer, const float* sbnw, const bf16* PROJ, bf16* OMIX, LAS unsigned char* wl, int lane) {
    const int bh = u >> 7, b = bh >> 2, h = bh & 3, tq0 = (u & 127) * 32, n = lane & 31, hh = lane >> 5;
    const bf16* base = PROJ + (size_t)(b * SEQ) * DINP;
    constexpr float SC = 0.125f * 1.4426950408889634f;
    bf16x8 qf[4];
    { const bf16* qp = base + (size_t)(tq0 + n) * DINP + C_SQ + h * 64 + 8 * hh;
#pragma unroll
      for (int ks = 0; ks < 4; ++ks) qf[ks] = *(const bf16x8*)(qp + 16 * ks); }
    bf16x8 ut[2];
#pragma unroll
    for (int s = 0; s < 2; ++s) { unsigned w[4];
#pragma unroll
        for (int i = 0; i < 4; ++i) { const int j0 = 2 * i, j1 = 2 * i + 1; const int k0 = 16 * s + 8 * (j0 >> 2) + 4 * hh + (j0 & 3), k1 = 16 * s + 8 * (j1 >> 2) + 4 * hh + (j1 & 3);
            w[i] = (k0 >= n ? 0x3F80u : 0u) | (k1 >= n ? 0x3F800000u : 0u); }
        ut[s] = mk8(w[0], w[1], w[2], w[3]); }
    f32x16 O0, O1;
#pragma unroll
    for (int r = 0; r < 16; ++r) { O0[r] = 0.f; O1[r] = 0.f; }
    float carry = 0.f;
    const int srow = lane >> 1, sp0 = (lane & 1) * 4;
    const bf16* kg = base + (size_t)srow * DINP + C_SK + h * 64 + sp0 * 8;
    const bf16* vg = base + (size_t)srow * DINP + C_SV + h * 64 + sp0 * 8;
    LAS unsigned char* sdst = wl + srow * SB_STRIDE + sp0 * 16;
    v4u kr[4], vr[4];
#pragma unroll
    for (int i = 0; i < 4; ++i) { kr[i] = *(const v4u*)(kg + (size_t)tq0 * DINP + 8 * i); vr[i] = *(const v4u*)(vg + (size_t)tq0 * DINP + 8 * i); }
#pragma unroll
    for (int i = 0; i < 4; ++i) { *(LAS v4u*)(sdst + 16 * i) = kr[i]; *(LAS v4u*)(sdst + 32 * SB_STRIDE + 16 * i) = vr[i]; }
    for (int k0 = tq0;; k0 -= 32) {
        const bool more = k0 > 0; const int kn = more ? k0 - 32 : 0;
#pragma unroll
        for (int i = 0; i < 4; ++i) { kr[i] = *(const v4u*)(kg + (size_t)kn * DINP + 8 * i); vr[i] = *(const v4u*)(vg + (size_t)kn * DINP + 8 * i); }
        __builtin_amdgcn_sched_barrier(0);
        {
            const LAS unsigned char* Kt = wl; const LAS unsigned char* Vt = wl + 32 * SB_STRIDE;
            const bool diag = (k0 == tq0);
            f32x16 acc;
#pragma unroll
            for (int r = 0; r < 16; ++r) acc[r] = 0.f;
            { const LAS unsigned char* kp = Kt + n * SB_STRIDE + hh * 16;
#pragma unroll
              for (int ks = 0; ks < 4; ++ks) { const bf16x8 kf = *(const LAS bf16x8*)(kp + ks * 32); acc = __builtin_amdgcn_mfma_f32_32x32x16_bf16(kf, qf[ks], acc, 0, 0, 0); } }
            float z[16], sp[16], lo[16];
#pragma unroll
            for (int r = 0; r < 16; ++r) { z[r] = acc[r] * SC; const bool valid = !diag || (crow(r, hh) < n);
                const float e = __builtin_amdgcn_exp2f(z[r]); float s = __builtin_amdgcn_logf(1.0f + e); s = z[r] > 24.f ? z[r] : s; sp[r] = valid ? s : 0.f; }
            unsigned hw[8];
#pragma unroll
            for (int i = 0; i < 8; ++i) { hw[i] = cvtpk(sp[2 * i], sp[2 * i + 1]); lo[2 * i] = sp[2 * i] - __uint_as_float(hw[i] << 16); lo[2 * i + 1] = sp[2 * i + 1] - __uint_as_float(hw[i] & 0xffff0000u); }
            f32x16 cum;
#pragma unroll
            for (int r = 0; r < 16; ++r) cum[r] = carry;
            cum = __builtin_amdgcn_mfma_f32_32x32x16_bf16(ut[0], mk8(hw[0], hw[1], hw[2], hw[3]), cum, 0, 0, 0);
            cum = __builtin_amdgcn_mfma_f32_32x32x16_bf16(ut[1], mk8(hw[4], hw[5], hw[6], hw[7]), cum, 0, 0, 0);
            cum = __builtin_amdgcn_mfma_f32_32x32x16_bf16(ut[0], pack8(lo), cum, 0, 0, 0);
            cum = __builtin_amdgcn_mfma_f32_32x32x16_bf16(ut[1], pack8(lo + 8), cum, 0, 0, 0);
            float av[16];
#pragma unroll
            for (int r = 0; r < 16; ++r) { const bool valid = !diag || (crow(r, hh) < n); av[r] = valid ? __builtin_amdgcn_exp2f(z[r] - cum[r]) : 0.f; }
            carry = half_bcast_lo(cum[0]);
            const bf16x8 pa0 = pack8(av), pa1 = pack8(av + 8);
            const int vcol = 16 * ((lane >> 4) & 1);
            O0 = __builtin_amdgcn_mfma_f32_32x32x16_bf16(tr_frag(Vt, SB_STRIDE, 4 * hh, vcol, lane), pa0, O0, 0, 0, 0);
            O0 = __builtin_amdgcn_mfma_f32_32x32x16_bf16(tr_frag(Vt, SB_STRIDE, 16 + 4 * hh, vcol, lane), pa1, O0, 0, 0, 0);
            O1 = __builtin_amdgcn_mfma_f32_32x32x16_bf16(tr_frag(Vt, SB_STRIDE, 4 * hh, 32 + vcol, lane), pa0, O1, 0, 0, 0);
            O1 = __builtin_amdgcn_mfma_f32_32x32x16_bf16(tr_frag(Vt, SB_STRIDE, 16 + 4 * hh, 32 + vcol, lane), pa1, O1, 0, 0, 0);
        }
        const bool live = __builtin_amdgcn_ballot_w64(!(carry > SB_EXIT)) != 0ull;
        if (!more || !live) break;
#pragma unroll
        for (int i = 0; i < 4; ++i) { *(LAS v4u*)(sdst + 16 * i) = kr[i]; *(LAS v4u*)(sdst + 32 * SB_STRIDE + 16 * i) = vr[i]; }
    }
    float ss = 0.f;
#pragma unroll
    for (int r = 0; r < 16; ++r) ss += O0[r] * O0[r] + O1[r] * O1[r];
    ss = half_sum(ss);
    const float rn = rsqrtf(ss * (1.0f / 64.0f) + EPS);
    const float* nw = sbnw + layer * 64;
    bf16* op = OMIX + (size_t)(b * SEQ + tq0 + n) * D + 768 + h * 64;
#pragma unroll
    for (int md = 0; md < 2; ++md)
#pragma unroll
        for (int r4 = 0; r4 < 4; ++r4) { const int d0 = 32 * md + 8 * r4 + 4 * hh; const f32x4 g = *(const f32x4*)(nw + d0);
            const float y0 = (md ? O1[4 * r4] : O0[4 * r4]) * rn * g[0], y1 = (md ? O1[4 * r4 + 1] : O0[4 * r4 + 1]) * rn * g[1], y2 = (md ? O1[4 * r4 + 2] : O0[4 * r4 + 2]) * rn * g[2], y3 = (md ? O1[4 * r4 + 3] : O0[4 * r4 + 3]) * rn * g[3];
            u32x2 w; w.x = cvtpk(y0, y1); w.y = cvtpk(y2, y3); *(u32x2*)(op + d0) = w; }
}
constexpr int DSW_STRIDE = 144, DSW_ROWS = 384, DSW_VOFF = DSW_ROWS * DSW_STRIDE;
constexpr size_t DSWO_CFG = (size_t)T * 384, DSWL_OFF = 72 * MiB, DSWL_CFG = (size_t)T * 6;
struct DswU { int b, h, r, rho, nb; };
__device__ __forceinline__ DswU dsw_decode(int u) { DswU d; const int bh = u / 48, rem = u % 48, cfg = rem >> 4, sub = rem & 15; d.b = bh / 6; d.h = bh % 6; d.r = cfg == 0 ? 1 : (cfg == 1 ? 4 : 16);
    const int nsb = 16 / d.r; d.rho = sub / nsb; d.nb = sub % nsb; return d; }
__device__ __forceinline__ void dsw_fetch(const DswU& d, const bf16* PROJ, v4u (&kr)[6], v4u (&vr)[6], bf16x8 (&qn)[4], int tid) {
    { const int lane_ = tid & 63, wave_ = tid >> 6; const int tokq_ = (256 * d.nb + 32 * wave_ + (lane_ & 31)) * d.r + d.rho;
      const bf16* qp = PROJ + (size_t)(d.b * SEQ + tokq_) * DINP + C_DQ + d.h * 64 + 8 * (lane_ >> 5);
#pragma unroll
      for (int ks = 0; ks < 4; ++ks) qn[ks] = *(const bf16x8*)(qp + 16 * ks); }
    const bf16* base = PROJ + (size_t)(d.b * SEQ) * DINP + d.h * 64 + (tid & 7) * 8;
#pragma unroll
    for (int i = 0; i < 6; ++i) { const int ks = 256 * d.nb - 128 + (tid >> 3) + 64 * i; const int kc = ks < 0 ? 0 : ks;
        const bf16* rp = base + (size_t)(kc * d.r + d.rho) * DINP; kr[i] = *(const v4u*)(rp + C_DK); vr[i] = *(const v4u*)(rp + C_DV); }
}
__device__ __forceinline__ void dsw_stage(const v4u (&kr)[6], const v4u (&vr)[6], int nb, LAS unsigned char* lds, int tid) {
#pragma unroll
    for (int i = 0; i < 6; ++i) { LAS unsigned char* p = lds + ((tid >> 3) + 64 * i) * DSW_STRIDE + (tid & 7) * 16; const bool ok = 256 * nb - 128 + (tid >> 3) + 64 * i >= 0; const v4u z = {0u, 0u, 0u, 0u};
        *(LAS v4u*)p = ok ? kr[i] : z; *(LAS v4u*)(p + DSW_VOFF) = ok ? vr[i] : z; }
}
__device__ __forceinline__ void dsw_compute(const DswU& d, int cfg, const bf16x8 (&qf)[4], bf16* DSWO, float* DSWL, const LAS unsigned char* lds, int wave, int lane) {
    int n_ = lane & 31, hh_ = lane >> 5; asm volatile("" : "+v"(n_), "+v"(hh_));
    const int n = n_, hh = hh_;
    constexpr float SC = 0.125f * 1.4426950408889634f;
    const float slope2 = exp2f(-8.0f * (float)(d.h + 1) / 6.0f) * (float)d.r * 1.4426950408889634f;
    const int tokq = (256 * d.nb + 32 * wave + n) * d.r + d.rho;
    float sc[5][16]; float mx = -3.0e38f;
    const bool first = (d.nb == 0);
    const int nq = n - 4 * hh; const float nbase = -slope2 * (float)(nq + 128);
#pragma unroll
    for (int j = 0; j < 5; ++j) {
        if (first && wave + j < 4) {
#pragma unroll
            for (int r = 0; r < 16; ++r) sc[j][r] = -3.0e38f;
        } else {
            f32x16 acc;
#pragma unroll
            for (int r = 0; r < 16; ++r) acc[r] = 0.f;
            const LAS unsigned char* kp = lds + (32 * (wave + j) + n) * DSW_STRIDE + hh * 16;
#pragma unroll
            for (int ks = 0; ks < 4; ++ks) { const bf16x8 kf = *(const LAS bf16x8*)(kp + ks * 32); acc = __builtin_amdgcn_mfma_f32_32x32x16_bf16(kf, qf[ks], acc, 0, 0, 0); }
#pragma unroll
            for (int r = 0; r < 16; ++r) { const int cr = (r & 3) + 8 * (r >> 2); const float bias = slope2 * (float)(32 * j + cr) + nbase;
                float v = acc[r] * SC + bias;
                if (j == 0) v = (cr >= nq) ? v : -3.0e38f;
                if (j == 4) v = (cr <= nq) ? v : -3.0e38f;
                sc[j][r] = v; mx = fmaxf(mx, v); }
        }
    }
    mx = half_max(mx);
    float l = 0.f;
#pragma unroll
    for (int j = 0; j < 5; ++j)
#pragma unroll
        for (int r = 0; r < 16; ++r) { const float p = __builtin_amdgcn_exp2f(sc[j][r] - mx); sc[j][r] = p; l += p; }
    l = half_sum(l);
    f32x16 O0, O1;
#pragma unroll
    for (int r = 0; r < 16; ++r) { O0[r] = 0.f; O1[r] = 0.f; }
    const int vcol = 16 * ((lane >> 4) & 1);
#pragma unroll
    for (int j = 0; j < 5; ++j) { const LAS unsigned char* Vt = lds + DSW_VOFF + 32 * (wave + j) * DSW_STRIDE;
        const bf16x8 pa0 = pack8(sc[j]), pa1 = pack8(sc[j] + 8);
        O0 = __builtin_amdgcn_mfma_f32_32x32x16_bf16(tr_frag(Vt, DSW_STRIDE, 4 * hh, vcol, lane), pa0, O0, 0, 0, 0);
        O0 = __builtin_amdgcn_mfma_f32_32x32x16_bf16(tr_frag(Vt, DSW_STRIDE, 16 + 4 * hh, vcol, lane), pa1, O0, 0, 0, 0);
        O1 = __builtin_amdgcn_mfma_f32_32x32x16_bf16(tr_frag(Vt, DSW_STRIDE, 4 * hh, 32 + vcol, lane), pa0, O1, 0, 0, 0);
        O1 = __builtin_amdgcn_mfma_f32_32x32x16_bf16(tr_frag(Vt, DSW_STRIDE, 16 + 4 * hh, 32 + vcol, lane), pa1, O1, 0, 0, 0); }
    const float il = 1.0f / l;
    const size_t trow = (size_t)(d.b * SEQ + tokq);
    bf16* op = DSWO + (size_t)cfg * DSWO_CFG + trow * 384 + d.h * 64;
#pragma unroll
    for (int md = 0; md < 2; ++md)
#pragma unroll
        for (int r4 = 0; r4 < 4; ++r4) { const int d0 = 32 * md + 8 * r4 + 4 * hh;
            const float y0 = (md ? O1[4 * r4] : O0[4 * r4]) * il, y1 = (md ? O1[4 * r4 + 1] : O0[4 * r4 + 1]) * il, y2 = (md ? O1[4 * r4 + 2] : O0[4 * r4 + 2]) * il, y3 = (md ? O1[4 * r4 + 3] : O0[4 * r4 + 3]) * il;
            u32x2 w; w.x = cvtpk(y0, y1); w.y = cvtpk(y2, y3); *(u32x2*)(op + d0) = w; }
    if (hh == 0) DSWL[(size_t)cfg * DSWL_CFG + trow * 6 + d.h] = mx + __builtin_amdgcn_logf(l);
}
__device__ __forceinline__ void dsw_phase(const bf16* PROJ, bf16* DSWO, float* DSWL, LAS unsigned char* lds, int vcu, int G, int wave, int lane, int tid) {
    v4u kr[6], vr[6]; bf16x8 qn[4], qc[4];
    int u = vcu;
    if (u >= 2304) return;
    DswU d = dsw_decode(u);
    dsw_fetch(d, PROJ, kr, vr, qn, tid); dsw_stage(kr, vr, d.nb, lds, tid);
    __syncthreads();
    for (;;) {
        const int un = u + G; const bool has_next = un < 2304; DswU dn = d;
#pragma unroll
        for (int ks = 0; ks < 4; ++ks) qc[ks] = qn[ks];
        dn = dsw_decode(has_next ? un : u); dsw_fetch(dn, PROJ, kr, vr, qn, tid);
        __builtin_amdgcn_sched_barrier(0);
        dsw_compute(d, (u % 48) >> 4, qc, DSWO, DSWL, lds, wave, lane);
        __syncthreads();
        if (!has_next) break;
        dsw_stage(kr, vr, dn.nb, lds, tid);
        __syncthreads();
        u = un; d = dn;
    }
}
__device__ __forceinline__ void dsw_combine_phase(const bf16* DSWO, const float* DSWL, const float* nw, bf16* OMIX, int gw, int NGW, int lane) {
    const int seg = lane & 7; const f32x4 g0 = *(const f32x4*)(nw + seg * 8), g1 = *(const f32x4*)(nw + seg * 8 + 4);
    for (int it = gw; it < T * 6 / 8; it += NGW) { const int item = it * 8 + (lane >> 3); const int t = item / 6, h = item % 6;
        const float l0 = DSWL[(size_t)t * 6 + h], l1 = DSWL[DSWL_CFG + (size_t)t * 6 + h], l2 = DSWL[2 * DSWL_CFG + (size_t)t * 6 + h];
        const float m = fmaxf(l0, fmaxf(l1, l2)); float w0 = __builtin_amdgcn_exp2f(l0 - m), w1 = __builtin_amdgcn_exp2f(l1 - m), w2 = __builtin_amdgcn_exp2f(l2 - m); const float iw = 1.0f / (w0 + w1 + w2); w0 *= iw; w1 *= iw; w2 *= iw;
        const bf16* p0 = DSWO + (size_t)t * 384 + h * 64 + seg * 8;
        const v4u a = *(const v4u*)p0, b = *(const v4u*)(p0 + DSWO_CFG), c = *(const v4u*)(p0 + 2 * DSWO_CFG);
        float o[8];
        o[0] = w0 * bflo(a.x) + w1 * bflo(b.x) + w2 * bflo(c.x); o[1] = w0 * bfhi(a.x) + w1 * bfhi(b.x) + w2 * bfhi(c.x);
        o[2] = w0 * bflo(a.y) + w1 * bflo(b.y) + w2 * bflo(c.y); o[3] = w0 * bfhi(a.y) + w1 * bfhi(b.y) + w2 * bfhi(c.y);
        o[4] = w0 * bflo(a.z) + w1 * bflo(b.z) + w2 * bflo(c.z); o[5] = w0 * bfhi(a.z) + w1 * bfhi(b.z) + w2 * bfhi(c.z);
        o[6] = w0 * bflo(a.w) + w1 * bflo(b.w) + w2 * bflo(c.w); o[7] = w0 * bfhi(a.w) + w1 * bfhi(b.w) + w2 * bfhi(c.w);
        float ss = 0.f;
#pragma unroll
        for (int i = 0; i < 8; ++i) ss += o[i] * o[i];
        ss += SWZ_XOR(ss, 1); ss += SWZ_XOR(ss, 2); ss += SWZ_XOR(ss, 4);
        const float rn = rsqrtf(ss * (1.0f / 64.0f) + EPS);
        v4u w; w.x = pk2(o[0] * rn * g0[0], o[1] * rn * g0[1]); w.y = pk2(o[2] * rn * g0[2], o[3] * rn * g0[3]); w.z = pk2(o[4] * rn * g1[0], o[5] * rn * g1[1]); w.w = pk2(o[6] * rn * g1[2], o[7] * rn * g1[3]);
        *(v4u*)(OMIX + (size_t)t * D + 384 + h * 64 + seg * 8) = w; }
}
constexpr size_t GDN_A = 0, GDN_B = 24 * MiB, GDN_C = 72 * MiB, GDN_D = 96 * MiB, GDN_ST = 120 * MiB, GDN_GT = 144 * MiB;
constexpr int GS = 144;
constexpr int GL_Q = 0, GL_K = 9216, GL_V = 18432, GL_L = 27648, GL_W = 27648, GL_QK = 46080, GL_U = 55296, GL_VEC = 64512, GL_BYTES = 65536;
__device__ __forceinline__ bf16x8 frag16_row(const LAS unsigned char* Tt, int x0, int k0, int lane) { return *(const LAS bf16x8*)(Tt + (x0 + (lane & 15)) * GS + (k0 + 8 * (lane >> 4)) * 2); }
__device__ __forceinline__ bf16x8 frag16_tr(const LAS unsigned char* Tt, int k0, int x0, int lane) {
    const LAS unsigned char* p = Tt + (k0 + 8 * (lane >> 4) + ((lane & 15) >> 2)) * GS + (x0 + 4 * (lane & 3)) * 2;
    const v4i16_t a = __builtin_amdgcn_ds_read_tr16_b64_v4i16((LAS v4i16_t*)p);
    const v4i16_t b = __builtin_amdgcn_ds_read_tr16_b64_v4i16((LAS v4i16_t*)(p + 4 * GS));
    return (bf16x8){a[0], a[1], a[2], a[3], b[0], b[1], b[2], b[3]};
}
#define MFMA16(a, b, c) __builtin_amdgcn_mfma_f32_16x16x32_bf16((a), (b), (c), 0, 0, 0)

typedef float f32x2g __attribute__((ext_vector_type(2)));
__device__ __forceinline__ void gdn_solve_col(f32x2g (&xp)[32], const LAS float* Lf) {
#pragma unroll
    for (int b = 0; b < 16; ++b) { const int i0 = 4 * b;
        const LAS float* Lb = Lf + i0 * 72;
        if (b > 0) asm volatile("" : "+v"(Lb) : "v"(xp[2 * b - 1]));
        f32x2g sa[4], sb[4];
#pragma unroll
        for (int r = 0; r < 4; ++r) { sa[r] = (f32x2g){0.f, 0.f}; sb[r] = (f32x2g){0.f, 0.f}; }
#pragma unroll
        for (int j4 = 0; j4 < b; ++j4)
#pragma unroll
            for (int r = 0; r < 4; ++r) { const f32x4 l = *(const LAS f32x4*)(Lb + r * 72 + 4 * j4);
                sa[r] += __builtin_shufflevector(l, l, 0, 1) * xp[2 * j4]; sb[r] += __builtin_shufflevector(l, l, 2, 3) * xp[2 * j4 + 1]; }
        const f32x4 d1 = *(const LAS f32x4*)(Lb + 1 * 72 + i0), d2 = *(const LAS f32x4*)(Lb + 2 * 72 + i0), d3 = *(const LAS f32x4*)(Lb + 3 * 72 + i0);
        float t[4];
#pragma unroll
        for (int r = 0; r < 4; ++r) t[r] = (sa[r][0] + sa[r][1]) + (sb[r][0] + sb[r][1]);
        const float x0 = xp[2 * b][0] - t[0];
        const float x1 = xp[2 * b][1] - (t[1] + d1[0] * x0);
        const float x2 = xp[2 * b + 1][0] - (t[2] + d2[0] * x0 + d2[1] * x1);
        const float x3 = xp[2 * b + 1][1] - (t[3] + d3[0] * x0 + d3[1] * x1 + d3[2] * x2);
        xp[2 * b] = (f32x2g){x0, x1}; xp[2 * b + 1] = (f32x2g){x2, x3}; }
}

__device__ __forceinline__ void gdn_g1_phase(int layer, const float* convw, const float* alog, const float* dtbias, const bf16* PROJ, unsigned char* gws, LAS unsigned char* lds, int vcu, int G, int wave, int lane_in, int tid_in) {
    const int grp = wave >> 2, gw4 = wave & 3;
    LAS unsigned char* gl = lds + grp * GL_BYTES;
    LAS float* vec = (LAS float*)(gl + GL_VEC);
    const float* cw = convw + (size_t)layer * 4 * 1152;
#define G1_BAR() do { asm volatile("s_waitcnt lgkmcnt(0)" ::: "memory"); __builtin_amdgcn_s_barrier(); asm volatile("" ::: "memory"); } while (0)
#define G1_LOADS(PP, AL, BL) do { int gt_ = tid_in & 255; asm volatile("" : "+v"(gt_)); const int c_ = 2 * (PP) + grp, bh_ = c_ >> 6, n_ = c_ & 63, b_ = bh_ / 6, h_ = bh_ % 6; const bf16* base_ = PROJ + (size_t)(b_ * SEQ) * DINP; \
        _Pragma("unroll") for (int i = 0; i < 3; ++i) { const int q = gt_ + 256 * i, w = q / 192, rem = q % 192; tap[i] = cw[w * 1152 + (rem >> 6) * 384 + h_ * 64 + (rem & 63)]; } \
        { const bf16* gbp = base_ + (size_t)(n_ * 64 + (gt_ & 63)) * DINP; AL = gbp[C_GA + h_]; BL = gbp[C_GB + h_]; } \
        _Pragma("unroll") for (int it = 0; it < 6; ++it) { const int idx = it * 256 + gt_, seg = idx & 7, rp = idx >> 3, part = it >> 1, row = rp & 63, pos = n_ * 64 + row; const int ch = part * 384 + h_ * 64 + seg * 8; \
            _Pragma("unroll") for (int w = 0; w < 4; ++w) { const int p = pos - 3 + w; xr[it][w] = *(const v4u*)(base_ + (size_t)(p < 0 ? 0 : p) * DINP + ch); } } } while (0)
    if (vcu >= 1536) return;
    float tap[3]; v4u xr[6][4]; bf16 al_b, bl_b, al_n, bl_n;
    G1_LOADS(vcu, al_b, bl_b);
    for (int pp = vcu;;) {
        int lane_ = lane_in, gtid_ = tid_in & 255; asm volatile("" : "+v"(lane_), "+v"(gtid_));
        const int lane = lane_, gtid = gtid_;
        const int c = 2 * pp + grp, bh = c >> 6, n = c & 63, b = bh / 6, h = bh % 6;
        LAS float* cwl = (LAS float*)(gl + GL_QK);
#pragma unroll
        for (int i = 0; i < 3; ++i) cwl[gtid + 256 * i] = tap[i];
        G1_BAR();
#pragma unroll
        for (int it = 0; it < 6; ++it) { const int idx = it * 256 + gtid, seg = idx & 7, rp = idx >> 3, part = it >> 1, row = rp & 63, pos = n * 64 + row;
            float y[8];
#pragma unroll
            for (int e = 0; e < 8; ++e) y[e] = 0.f;
#pragma unroll
            for (int w = 0; w < 4; ++w) { v4u x = xr[it][w]; if (pos - 3 + w < 0) x = (v4u){0u, 0u, 0u, 0u};
                const LAS f32x4* cp = (const LAS f32x4*)(cwl + w * 192 + part * 64 + seg * 8); const f32x4 c0 = cp[0], c1 = cp[1];
                y[0] += c0[0] * bflo(x.x); y[1] += c0[1] * bfhi(x.x); y[2] += c0[2] * bflo(x.y); y[3] += c0[3] * bfhi(x.y); y[4] += c1[0] * bflo(x.z); y[5] += c1[1] * bfhi(x.z); y[6] += c1[2] * bflo(x.w); y[7] += c1[3] * bfhi(x.w); }
            float ss = 0.f;
#pragma unroll
            for (int e = 0; e < 8; ++e) { y[e] = silu_f(y[e]); ss += y[e] * y[e]; }
            if (part < 2) { ss += SWZ_XOR(ss, 1); ss += SWZ_XOR(ss, 2); ss += SWZ_XOR(ss, 4); const float rn = rsqrtf(ss + EPS);
#pragma unroll
                for (int e = 0; e < 8; ++e) y[e] *= rn; }
            v4u o; o.x = cvtpk(y[0], y[1]); o.y = cvtpk(y[2], y[3]); o.z = cvtpk(y[4], y[5]); o.w = cvtpk(y[6], y[7]);
            *(LAS v4u*)(gl + (part == 0 ? GL_Q : (part == 1 ? GL_K : GL_V)) + row * GS + seg * 16) = o; }
        if (gw4 == 0) { float gv = -expf(alog[layer * 6 + h]) * softplus_f(bf2f(al_b) + dtbias[layer * 6 + h]); const float bv = sigm_f(bf2f(bl_b));
#pragma unroll
            for (int off = 1; off < 64; off <<= 1) { const float t_ = __int_as_float(__builtin_amdgcn_ds_bpermute(((lane - off) & 63) << 2, __float_as_int(gv))); if (lane >= off) gv += t_; }
            const float Gt = __int_as_float(__builtin_amdgcn_readlane(__float_as_int(gv), 63));
            vec[lane] = gv; vec[64 + lane] = bv; vec[128 + lane] = __expf(gv); vec[192 + lane] = __expf(Gt - gv); }
        G1_BAR();
        f32x2g xp[32];
        const bool solver = (gw4 >> 1) == grp;
        const int scol = (gw4 & 1) * 64 + lane;
        if (solver) { const int col = scol;
            const LAS bf16* src = (const LAS bf16*)(gl + (col < 64 ? GL_V : GL_K)) + (col & 63);
#pragma unroll
            for (int i = 0; i < 64; ++i) { const float bi = vec[64 + i]; xp[i >> 1][i & 1] = bf2f(src[i * 72]) * bi * (col < 64 ? 1.0f : vec[128 + i]); } }
        { const int q4 = lane >> 4, cl = lane & 15;
          bf16x8 ka[2], qa[2];
#pragma unroll
          for (int ks = 0; ks < 2; ++ks) { ka[ks] = frag16_row(gl + GL_K, 16 * gw4, 32 * ks, lane); qa[ks] = frag16_row(gl + GL_Q, 16 * gw4, 32 * ks, lane); }
          float Gr[4], br[4];
#pragma unroll
          for (int r = 0; r < 4; ++r) { Gr[r] = vec[16 * gw4 + 4 * q4 + r]; br[r] = vec[64 + 16 * gw4 + 4 * q4 + r]; }
#pragma unroll
          for (int nj = 0; nj < 4; ++nj) {
              LAS float* Lp = (LAS float*)(gl + GL_L); LAS bf16* QKp = (LAS bf16*)(gl + GL_QK);
              if (nj <= gw4) {
                  f32x4 kk = {0.f, 0.f, 0.f, 0.f}, qk = {0.f, 0.f, 0.f, 0.f};
#pragma unroll
                  for (int ks = 0; ks < 2; ++ks) { const bf16x8 kb = frag16_row(gl + GL_K, 16 * nj, 32 * ks, lane); kk = MFMA16(ka[ks], kb, kk); qk = MFMA16(qa[ks], kb, qk); }
                  const int j = 16 * nj + cl; const float Gj = vec[j];
#pragma unroll
                  for (int r = 0; r < 4; ++r) { const int i = 16 * gw4 + 4 * q4 + r; const float dec = __expf(Gr[r] - Gj);
                      Lp[i * 72 + j] = (j < i) ? br[r] * kk[r] * dec : 0.f;
                      QKp[i * 72 + j] = (bf16)f2bf((j <= i) ? qk[r] * 0.125f * dec : 0.f); }
              } else {
#pragma unroll
                  for (int r = 0; r < 4; ++r) { const int i = 16 * gw4 + 4 * q4 + r; QKp[i * 72 + 16 * nj + cl] = (bf16)0; }
              } } }
        G1_BAR();
        if (solver) gdn_solve_col(xp, (const LAS float*)(gl + GL_L));
        else {
#pragma unroll
            for (int it = 0; it < 4; ++it) { const int idx = it * 128 + scol, row = idx >> 3, seg = idx & 7; LAS v4u* p = (LAS v4u*)(gl + GL_K + row * GS + seg * 16); const v4u k = *p; const float s = vec[192 + row];
                v4u o; o.x = cvtpk(bflo(k.x) * s, bfhi(k.x) * s); o.y = cvtpk(bflo(k.y) * s, bfhi(k.y) * s); o.z = cvtpk(bflo(k.z) * s, bfhi(k.z) * s); o.w = cvtpk(bflo(k.w) * s, bfhi(k.w) * s); *p = o; } }
        G1_BAR();
        if (solver) { const int col = scol; LAS unsigned char* dst = gl + (col < 64 ? GL_U : GL_W) + (col & 63) * GS;
#pragma unroll
            for (int jj = 0; jj < 8; ++jj) { v4u o; o.x = cvtpk(xp[4 * jj][0], xp[4 * jj][1]); o.y = cvtpk(xp[4 * jj + 1][0], xp[4 * jj + 1][1]); o.z = cvtpk(xp[4 * jj + 2][0], xp[4 * jj + 2][1]); o.w = cvtpk(xp[4 * jj + 3][0], xp[4 * jj + 3][1]); *(LAS v4u*)(dst + 16 * jj) = o; } }
        G1_BAR();
        const int ppn = pp + G; const bool has_next = ppn < 1536;
        G1_LOADS(has_next ? ppn : pp, al_n, bl_n);
        __builtin_amdgcn_sched_barrier(0);
        { const int q4 = lane >> 4, cl = lane & 15, m0 = 16 * gw4 + 4 * q4, pm = 16 * q4 + 4 * gw4;
          const size_t cs = (size_t)(n * 48 + bh) * 4096;
          bf16* Ag = (bf16*)(gws + GDN_A) + cs; bf16* Bg = (bf16*)(gws + GDN_B) + cs; bf16* Cg = (bf16*)(gws + GDN_C) + cs; bf16* Dg = (bf16*)(gws + GDN_D) + cs;
          bf16x8 wa[2], ua[2], kda[2];
#pragma unroll
          for (int ks = 0; ks < 2; ++ks) { wa[ks] = frag16_row(gl + GL_W, 16 * gw4, 32 * ks, lane); ua[ks] = frag16_row(gl + GL_U, 16 * gw4, 32 * ks, lane); kda[ks] = frag16_tr(gl + GL_K, 32 * ks, 16 * gw4, lane); }
#pragma unroll
          for (int nt = 0; nt < 4; ++nt) {
              f32x4 am = {0.f, 0.f, 0.f, 0.f}, bm = {0.f, 0.f, 0.f, 0.f}, cm = {0.f, 0.f, 0.f, 0.f}, dm = {0.f, 0.f, 0.f, 0.f};
#pragma unroll
              for (int ks = 0; ks < 2; ++ks) { const bf16x8 kdb = frag16_tr(gl + GL_K, 32 * ks, 16 * nt, lane), ub = frag16_row(gl + GL_U, 16 * nt, 32 * ks, lane), qkb = frag16_row(gl + GL_QK, 16 * nt, 32 * ks, lane);
                  am = MFMA16(wa[ks], kdb, am);
                  bm = MFMA16(kda[ks], ub, bm);
                  cm = MFMA16(wa[ks], qkb, cm);
                  dm = MFMA16(ua[ks], qkb, dm); }
              const int nn = 16 * nt + cl;
              { u32x2 o; o.x = cvtpk(-am[0], -am[1]); o.y = cvtpk(-am[2], -am[3]); *(u32x2*)(Ag + nn * 64 + pm) = o; }
              { u32x2 o; o.x = cvtpk(bm[0], bm[1]); o.y = cvtpk(bm[2], bm[3]); *(u32x2*)(Bg + nn * 64 + pm) = o; }
              { const u32x2 qv = *(const LAS u32x2*)(gl + GL_Q + nn * GS + m0 * 2); const float sq = vec[128 + nn] * 0.125f;
                u32x2 o; o.x = cvtpk(bflo(qv.x) * sq - cm[0], bfhi(qv.x) * sq - cm[1]); o.y = cvtpk(bflo(qv.y) * sq - cm[2], bfhi(qv.y) * sq - cm[3]); *(u32x2*)(Cg + nn * 64 + pm) = o; }
              { u32x2 o; o.x = cvtpk(dm[0], dm[1]); o.y = cvtpk(dm[2], dm[3]); *(u32x2*)(Dg + nn * 64 + pm) = o; }
          }
          if (gtid == 0) ((float*)(gws + GDN_GT))[c] = vec[128 + 63]; }
        G1_BAR();
        if (!has_next) break;
        pp = ppn; al_b = al_n; bl_b = bl_n;
    }
#undef G1_BAR
#undef G1_LOADS
}

struct ScanOps { bf16x8 af[4][2]; v4u bq[2]; };
#define SCAN_LOAD(R, nn) do { { const int nc_ = (nn) < 64 ? (nn) : 63;     \
    const bf16* An_ = Ag + (size_t)nc_ * (48 * 4096); const bf16* Bn_ = Bg + (size_t)nc_ * (48 * 4096) + (16 * es + cl) * 64 + 16 * q4; \
    _Pragma("unroll") for (int md = 0; md < 4; ++md) { _Pragma("unroll") for (int ks = 0; ks < 2; ++ks) R.af[md][ks] = *(const bf16x8*)(An_ + (16 * md + cl) * 64 + 32 * ks + 8 * q4); } \
    R.bq[0] = *(const v4u*)Bn_; R.bq[1] = *(const v4u*)(Bn_ + 8); } } while (0)
#define SCAN_BQ(R, md) (f32x4){bflo((md) & 1 ? R.bq[(md) >> 1].z : R.bq[(md) >> 1].x), bfhi((md) & 1 ? R.bq[(md) >> 1].z : R.bq[(md) >> 1].x), bflo((md) & 1 ? R.bq[(md) >> 1].w : R.bq[(md) >> 1].y), bfhi((md) & 1 ? R.bq[(md) >> 1].w : R.bq[(md) >> 1].y)}
#define SCAN_STEP(R, nn) do { \
    v4u o0_, o1_; o0_.x = cvtpk(S[0][0], S[0][1]); o0_.y = cvtpk(S[0][2], S[0][3]); o0_.z = cvtpk(S[1][0], S[1][1]); o0_.w = cvtpk(S[1][2], S[1][3]); \
    o1_.x = cvtpk(S[2][0], S[2][1]); o1_.y = cvtpk(S[2][2], S[2][3]); o1_.z = cvtpk(S[3][0], S[3][1]); o1_.w = cvtpk(S[3][2], S[3][3]); \
    { bf16* sp_ = STg + (size_t)(nn) * (48 * 4096) + (16 * es + cl) * 64 + 16 * q4; *(v4u*)sp_ = o0_; *(v4u*)(sp_ + 8) = o1_; } \
    *(LAS v4u*)(wl + cl * GS + q4 * 32) = o0_; *(LAS v4u*)(wl + cl * GS + q4 * 32 + 16) = o1_; \
    const bf16x8 sb0 = *(const LAS bf16x8*)(wl + cl * GS + (8 * q4) * 2), sb1 = *(const LAS bf16x8*)(wl + cl * GS + (32 + 8 * q4) * 2); \
    const float gt_ = __int_as_float(__builtin_amdgcn_readlane(__float_as_int(gtv), (nn))); \
    _Pragma("unroll") for (int md = 0; md < 4; ++md) { f32x4 a_ = S[md] * gt_ + SCAN_BQ(R, md); \
        a_ = MFMA16(R.af[md][0], sb0, a_); S[md] = MFMA16(R.af[md][1], sb1, a_); } } while (0)
constexpr int SCAN_LEAD = 16;
__device__ __forceinline__ void gdn_scan_prefetch(int su, const unsigned char* gws, const volatile LAS int* prog, int lane) {
    const int bh = su >> 2, es = su & 3;
    const unsigned char* pa = gws + GDN_A + (size_t)bh * 8192 + lane * 128;
    const unsigned char* pb = gws + GDN_B + (size_t)bh * 8192 + (16 * es + (lane & 15)) * 128;
    unsigned sink = 0u;
    for (int n = 0; n < 64; ++n) {
        if (n >= SCAN_LEAD) { int sp = 0; while (*prog < n - SCAN_LEAD && ++sp < 8192) __builtin_amdgcn_s_sleep(8); }
        asm volatile("global_load_dword %0, %1, off" : "+v"(sink) : "v"(pa) : "memory");
        asm volatile("global_load_dword %0, %1, off" : "+v"(sink) : "v"(pb) : "memory");
        pa += 48 * 8192; pb += 48 * 8192;
    }
    asm volatile("s_waitcnt vmcnt(0)" : "+v"(sink) :: "memory");
}
__device__ __forceinline__ void gdn_scan_unit(int su, unsigned char* gws, LAS unsigned char* wl  , int lane) {
    const int bh = su >> 2, es = su & 3, q4 = lane >> 4, cl = lane & 15;
    if (lane == 0) *(volatile LAS int*)(wl + 128) = 0;
    const bf16* Ag = (const bf16*)(gws + GDN_A) + (size_t)bh * 4096; const bf16* Bg = (const bf16*)(gws + GDN_B) + (size_t)bh * 4096;
    bf16* STg = (bf16*)(gws + GDN_ST) + (size_t)bh * 4096;
    const float gtv = ((const float*)(gws + GDN_GT))[bh * 64 + lane];
    f32x4 S[4];
#pragma unroll
    for (int md = 0; md < 4; ++md) S[md] = (f32x4){0.f, 0.f, 0.f, 0.f};
    ScanOps r0, r1, r2, r3;
    SCAN_LOAD(r0, 0); SCAN_LOAD(r1, 1); SCAN_LOAD(r2, 2); SCAN_LOAD(r3, 3);
    for (int n = 0; n < 64; n += 4) {
        if (lane == 0) *(volatile LAS int*)(wl + 128) = n;
        SCAN_STEP(r0, n); __builtin_amdgcn_sched_barrier(0); SCAN_LOAD(r0, n + 4); __builtin_amdgcn_sched_barrier(0);
        SCAN_STEP(r1, n + 1); __builtin_amdgcn_sched_barrier(0); SCAN_LOAD(r1, n + 5); __builtin_amdgcn_sched_barrier(0);
        SCAN_STEP(r2, n + 2); __builtin_amdgcn_sched_barrier(0); SCAN_LOAD(r2, n + 6); __builtin_amdgcn_sched_barrier(0);
        SCAN_STEP(r3, n + 3); __builtin_amdgcn_sched_barrier(0); SCAN_LOAD(r3, n + 7); __builtin_amdgcn_sched_barrier(0);
    }
}

struct G3Ops { bf16x8 cb[2]; bf16x8 sa[4][2]; u32x2 dv[4]; u32x2 zv[4]; };
#define G3_LOAD(R, wu_) do { const int w_ = (wu_) < 3072 * 4 ? (wu_) : 3072 * 4 - 1; const int c_ = w_ >> 2, ni_ = w_ & 3, bh_ = c_ >> 6, n_ = c_ & 63, b_ = bh_ / 6, h_ = bh_ % 6; \
    const size_t cs_ = (size_t)(n_ * 48 + bh_) * 4096; const bf16* STg_ = (const bf16*)(gws + GDN_ST) + cs_; const bf16* Cg_ = (const bf16*)(gws + GDN_C) + cs_; const bf16* Dg_ = (const bf16*)(gws + GDN_D) + cs_; \
    const bf16* zp_ = PROJ + (size_t)(b_ * SEQ + n_ * 64 + 16 * ni_ + cl) * DINP + C_GZ + h_ * 64; \
    _Pragma("unroll") for (int ks = 0; ks < 2; ++ks) R.cb[ks] = *(const bf16x8*)(Cg_ + (16 * ni_ + cl) * 64 + 32 * ks + 8 * q4); \
    _Pragma("unroll") for (int me = 0; me < 4; ++me) { R.dv[me] = *(const u32x2*)(Dg_ + (16 * ni_ + cl) * 64 + 16 * q4 + 4 * me); R.zv[me] = *(const u32x2*)(zp_ + 16 * me + 4 * q4); \
        _Pragma("unroll") for (int ks = 0; ks < 2; ++ks) R.sa[me][ks] = *(const bf16x8*)(STg_ + (16 * me + cl) * 64 + 32 * ks + 8 * q4); } } while (0)
__device__ __forceinline__ void gdn_g3_unit(const G3Ops& R, int wu, const float* nw, bf16* OMIX, int q4, int cl) {
    const int c = wu >> 2, ni = wu & 3, bh = c >> 6, n = c & 63, b = bh / 6, h = bh % 6;
    f32x4 o[4]; float ss = 0.f;
#pragma unroll
    for (int me = 0; me < 4; ++me) { o[me] = (f32x4){bflo(R.dv[me].x), bfhi(R.dv[me].x), bflo(R.dv[me].y), bfhi(R.dv[me].y)};
#pragma unroll
        for (int ks = 0; ks < 2; ++ks) o[me] = MFMA16(R.sa[me][ks], R.cb[ks], o[me]);
        ss += (o[me][0] * o[me][0] + o[me][1] * o[me][1]) + (o[me][2] * o[me][2] + o[me][3] * o[me][3]); }
    ss += SWZ_XOR(ss, 16); ss = half_sum(ss);
    const float rn = rsqrtf(ss * (1.0f / 64.0f) + EPS);
    bf16* op = OMIX + (size_t)(b * SEQ + n * 64 + 16 * ni + cl) * D + h * 64;
#pragma unroll
    for (int me = 0; me < 4; ++me) { const int e0 = 16 * me + 4 * q4; const u32x2 zv = R.zv[me]; const f32x4 g = *(const f32x4*)(nw + e0);
        u32x2 w; w.x = cvtpk(o[me][0] * rn * g[0] * silu_f(bflo(zv.x)), o[me][1] * rn * g[1] * silu_f(bfhi(zv.x))); w.y = cvtpk(o[me][2] * rn * g[2] * silu_f(bflo(zv.y)), o[me][3] * rn * g[3] * silu_f(bfhi(zv.y)));
        *(u32x2*)(op + e0) = w; }
}
__device__ __forceinline__ void gdn_g3_phase(int layer, const float* gnw, const bf16* PROJ, unsigned char* gws, bf16* OMIX, int gw, int NGW, int lane) {
    const int q4 = lane >> 4, cl = lane & 15; const float* nw = gnw + layer * 64;
    G3Ops r0, r1;
    G3_LOAD(r0, gw);
    for (int wu = gw; wu < 3072 * 4; wu += 2 * NGW) {
        G3_LOAD(r1, wu + NGW); __builtin_amdgcn_sched_barrier(0);
        gdn_g3_unit(r0, wu, nw, OMIX, q4, cl); __builtin_amdgcn_sched_barrier(0);
        G3_LOAD(r0, wu + 2 * NGW); __builtin_amdgcn_sched_barrier(0);
        if (wu + NGW < 3072 * 4) gdn_g3_unit(r1, wu + NGW, nw, OMIX, q4, cl);
        __builtin_amdgcn_sched_barrier(0);
    }
}
#define LAUNDER() do { ap = (const CAS Args*)__builtin_amdgcn_kernarg_segment_ptr(); asm volatile("" : "+s"(ap)); } while (0)
#define A_IN(i) ((const float*)ap->in[i])
#define WSP ((unsigned char*)ap->ws)
#define HOUT ((float*)ap->out)
#define LDSP ((LAS unsigned char*)lds_raw)
#define HD0 ((bf16*)ap->out)
#define HD1 ((bf16*)ap->out + (size_t)T * D)
__device__ __forceinline__ int GX() { int g = gridDim.x; asm volatile("" : "+s"(g)); return g; }
__device__ __forceinline__ int BX() { int b = blockIdx.x; asm volatile("" : "+s"(b)); return b; }
#define GRID_BAR() do { LAUNDER(); XcdBarrier b_; b_.bar = (unsigned*)(WSP + WS_CTL) + CW_BAR; b_.x = xb_xcc_id(); b_.st = (volatile LAS unsigned*)(LDSP + MISC_OFF) + 8; xcd_barrier(b_); } while (0)
#define IDS() int tid_ = wave_s * 64 + mk_lane(), bx_ = blockIdx.x, G_ = gridDim.x; asm volatile("" : "+v"(tid_), "+s"(bx_), "+s"(G_)); const int tid = tid_, lane = tid & 63, wave = __builtin_amdgcn_readfirstlane(tid >> 6); const int G = G_, bx = bx_; \
              const int vcu = (G % 8 == 0) ? (bx % 8) * (G / 8) + bx / 8 : bx; const int gw = vcu * NWAVES + wave, NGW = G * NWAVES; (void)gw; (void)NGW; (void)lane; (void)tid; (void)vcu
constexpr size_t ROWTOK_OFF = 131072 + 262144 + 262144;
static_assert(ROWTOK_OFF + (size_t)MROWS * 4 <= MiB, "ROUTE region");
template <int layer>
__device__ __forceinline__ void layer_body(const int wave_s) {
    extern __shared__ __attribute__((aligned(16))) unsigned char lds_raw[];
    const CAS Args* ap;
        { LAUNDER(); pg8::Gemm g{(const bf16*)HD0, (const bf16*)(WSP + WS_WIN) + (size_t)layer * DINP * D, T, DINP, D, D};     pg8::StaticOrder S; S.init(T, DINP, GX(), BX());
          pg8::build_row_scales(S, (const float*)(WSP + WS_STATA), (LAS float*)(LDSP + RTAB_OFF), wave_s * 64 + mk_lane());
          pg8::EpiStore<true> E{(bf16*)(WSP + WS_PROJ), DINP, 1 << 20, (const LAS float*)(LDSP + RTAB_OFF), 0};
          pg8::gemm_phase<pg8::EpiStore<true>, pg8::StaticOrder, true, true>(LDSP + RING_OFF, g, S, E, wave_s); }
        GRID_BAR();
        { IDS(); LAUNDER(); const bf16* PROJ = (const bf16*)(WSP + WS_PROJ); bf16* OMIX = (bf16*)(WSP + WS_OMIX);
          gdn_g1_phase(layer, A_IN(4), A_IN(5), A_IN(6), PROJ, WSP + WS_GDN, LDSP + RING_OFF, vcu, G, wave, lane, tid);
          __syncthreads(); }
        { IDS(); LAUNDER(); const bf16* PROJ = (const bf16*)(WSP + WS_PROJ); bf16* OMIX = (bf16*)(WSP + WS_OMIX);
          for (int u = gw; u < 4096; u += NGW) sb_wave_unit(u, layer, A_IN(9), PROJ, OMIX, LDSP + RING_OFF + wave * SB_WBYTES, lane);
          }
        GRID_BAR();
        { IDS(); LAUNDER(); const bf16* PROJ = (const bf16*)(WSP + WS_PROJ);
          if (wave == 1 && vcu < 192) gdn_scan_prefetch(vcu, WSP + WS_GDN, (const volatile LAS int*)(LDSP + RING_OFF + 110592 + 128), lane);
          if (wave == 0 && vcu < 192) gdn_scan_unit(vcu, WSP + WS_GDN, LDSP + RING_OFF + 110592, lane);
          dsw_phase(PROJ, (bf16*)(WSP + WS_DSW), (float*)(WSP + WS_DSW + DSWL_OFF), LDSP + RING_OFF, vcu, G, wave, lane, tid);
          }
        GRID_BAR();
        { IDS(); LAUNDER(); gdn_g3_phase(layer, A_IN(7), (const bf16*)(WSP + WS_PROJ), WSP + WS_GDN, (bf16*)(WSP + WS_OMIX), gw, NGW, lane); }
        { IDS(); LAUNDER(); dsw_combine_phase((const bf16*)(WSP + WS_DSW), (const float*)(WSP + WS_DSW + DSWL_OFF), A_IN(8) + layer * 64, (bf16*)(WSP + WS_OMIX), gw, NGW, lane); }
        GRID_BAR();
        { LAUNDER(); pg8::Gemm g{(const bf16*)(WSP + WS_OMIX), (const bf16*)(WSP + WS_WOUT) + (size_t)layer * D * D, T, D, D, D}; pg8::StaticOrder S; S.init(T, D, GX(), BX());
          pg8::EpiResid<(layer & 1) == 0> E{(const bf16*)HD0, (bf16*)(WSP + WS_HN), D, (float*)(WSP + WS_STATA)};
          pg8::gemm_phase<pg8::EpiResid<(layer & 1) == 0>, pg8::StaticOrder, true, true>(LDSP + RING_OFF, g, S, E, wave_s); }
        GRID_BAR();
        if ((layer & 1) == 0) {
            { IDS(); LAUNDER(); const float* p = A_IN(1) + (size_t)layer * T * PLE; bf16* PB = (bf16*)(WSP + WS_PB);
          for (size_t i = (size_t)(vcu * NTHR + tid); i < (size_t)T * PLE / 8; i += (size_t)G * NTHR) { const f32x4 x0 = *(const f32x4*)(p + 8 * i), x1 = *(const f32x4*)(p + 8 * i + 4);
              v4u o; o.x = pk2(x0[0], x0[1]); o.y = pk2(x0[2], x0[3]); o.z = pk2(x1[0], x1[1]); o.w = pk2(x1[2], x1[3]); *(v4u*)(PB + 8 * i) = o; } }
            { LAUNDER(); const int j = layer >> 1; pg8::Gemm g{(const bf16*)(WSP + WS_HN), (const bf16*)(WSP + WS_WF13) + (size_t)j * 2 * DFF * D, T, 2 * DFF, D, D}; pg8::StaticOrder S; S.init(T, 2 * DFF, GX(), BX());
              pg8::build_row_scales(S, (const float*)(WSP + WS_STATA), (LAS float*)(LDSP + RTAB_OFF), wave_s * 64 + mk_lane());
              pg8::EpiSwiGLU<true> E{(bf16*)(WSP + WS_ACT), DFF, 1 << 20, (const LAS float*)(LDSP + RTAB_OFF)};
              pg8::gemm_phase<pg8::EpiSwiGLU<true>, pg8::StaticOrder, true, true>(LDSP + RING_OFF, g, S, E, wave_s); }
            GRID_BAR();
            { LAUNDER(); const int j = layer >> 1; pg8::Gemm g{(const bf16*)(WSP + WS_ACT), (const bf16*)(WSP + WS_WF2) + (size_t)j * D * DFF, T, D, DFF, DFF}; pg8::StaticOrder S; S.init(T, D, GX(), BX());
              pg8::EpiResid<true> E{(const bf16*)(WSP + WS_HN), HD1, D, (float*)(WSP + WS_STATB)};
              pg8::gemm_phase<pg8::EpiResid<true>, pg8::StaticOrder, true, true>(LDSP + RING_OFF, g, S, E, wave_s); }
        } else {
            { IDS(); LAUNDER(); LAS float* rl = (LAS float*)(LDSP + RING_OFF); const float* rw = A_IN(15) + (size_t)(layer >> 1) * D * NE;
              for (int i = tid; i < D * NE; i += NTHR) rl[i] = rw[i];
              __syncthreads();
              norm_phase(WSP + WS_HN, false, A_IN(11) + layer * D, HD1, nullptr, 0, nullptr, nullptr, nullptr, nullptr, nullptr, true, rl, (int*)(WSP + WS_ROUTE), (float*)(WSP + WS_ROUTE + 131072), gw, NGW, lane);
              __syncthreads(); }
            GRID_BAR();
            { IDS(); LAUNDER(); moe_slot_phase((const int*)(WSP + WS_ROUTE), (int*)(WSP + WS_ROUTE + 131072 + 262144), (unsigned*)(WSP + WS_ROUTE + ROWTOK_OFF), LDSP, gw, NGW, wave, lane, tid); }
            GRID_BAR();
            { LAUNDER(); const int j = layer >> 1; const LAS int* tab = (const LAS int*)(LDSP + TILEE_OFF); const int Mp = tab[300];
              pg8::Gemm g{(const bf16*)HD1, (const bf16*)(WSP + WS_WM13) + (size_t)j * NE * 2 * MFF * D, Mp, 2 * MFF, D, D};     pg8::GroupedOrderT<true> S; S.init(Mp, 2 * MFF, GX(), BX(), tab); S.rowtok = (const unsigned*)(WSP + WS_ROUTE + ROWTOK_OFF); S.gtab = LDSP + RTAB_OFF;
              pg8::EpiSwiGLU<false> E{(bf16*)(WSP + WS_MACT), MFF, 2 * MFF / 256, nullptr};
              pg8::gemm_phase<pg8::EpiSwiGLU<false>, pg8::GroupedOrderT<true>, true, true>(LDSP + RING_OFF, g, S, E, wave_s); }
            GRID_BAR();
            { LAUNDER(); const int j = layer >> 1; const LAS int* tab = (const LAS int*)(LDSP + TILEE_OFF);
              pg8::Gemm g{(const bf16*)(WSP + WS_MACT), (const bf16*)(WSP + WS_WM2) + (size_t)j * NE * D * MFF, 2 * T, D, MFF, MFF}; pg8::GroupedOrder S; S.init(2 * T, D, GX(), BX(), tab);
              pg8::EpiStore<false> E{(bf16*)(WSP + WS_ASORT), D, D / 256, nullptr, 0};
              pg8::gemm_phase<pg8::EpiStore<false>, pg8::GroupedOrder, true, true>(LDSP + RING_OFF, g, S, E, wave_s); }
            { LAUNDER(); const int j = layer >> 1; const LAS int* tab = (const LAS int*)(LDSP + TILEE_OFF); const int Mp = tab[300];
              pg8::Gemm g{(const bf16*)(WSP + WS_MACT), (const bf16*)(WSP + WS_WM2) + (size_t)j * NE * D * MFF, Mp, D, MFF, MFF / 4}; pg8::TailOrder S; S.init(Mp, 2 * T / 256, MFF / 4, GX(), BX(), tab);
              pg8::EpiStore<false> E{HD0 - (size_t)2 * T * D, D, D / 256, nullptr, (long)2048 * D};
              pg8::gemm_phase<pg8::EpiStore<false>, pg8::TailOrder, true, true>(LDSP + RING_OFF, g, S, E, wave_s); }
            GRID_BAR();
            { IDS(); LAUNDER(); norm_phase(WSP + WS_HN, false, A_IN(20) + layer * D, HD1, nullptr, 1, (const bf16*)(WSP + WS_ASORT),   (const bf16*)HD0, (const int*)(WSP + WS_ROUTE + 131072 + 262144), (const float*)(WSP + WS_ROUTE + 131072), (float*)(WSP + WS_STATB), false, (const LAS float*)LDSP, nullptr, nullptr, gw, NGW, lane); }
            { IDS(); LAUNDER(); const float* p = A_IN(1) + (size_t)layer * T * PLE; bf16* PB = (bf16*)(WSP + WS_PB);
          for (size_t i = (size_t)(vcu * NTHR + tid); i < (size_t)T * PLE / 8; i += (size_t)G * NTHR) { const f32x4 x0 = *(const f32x4*)(p + 8 * i), x1 = *(const f32x4*)(p + 8 * i + 4);
              v4u o; o.x = pk2(x0[0], x0[1]); o.y = pk2(x0[2], x0[3]); o.z = pk2(x1[0], x1[1]); o.w = pk2(x1[2], x1[3]); *(v4u*)(PB + 8 * i) = o; } }
        }
        GRID_BAR();
        { LAUNDER(); pg8::Gemm g{(const bf16*)(WSP + WS_PB), (const bf16*)(WSP + WS_WPROJ) + (size_t)layer * D * PLE, T, D, PLE, PLE}; pg8::StaticOrder S; S.init(T, D, GX(), BX());
          pg8::EpiPleP E{(bf16*)(WSP + WS_POUT), D};
          pg8::gemm_phase<pg8::EpiPleP, pg8::StaticOrder, true, true>(LDSP + RING_OFF, g, S, E, wave_s); }
        { LAUNDER(); pg8::Gemm g{(const bf16*)HD1, (const bf16*)(WSP + WS_WGATE) + (size_t)layer * D * D, T, D, D, D}; pg8::StaticOrder S; S.init(T, D, GX(), BX());
          pg8::build_row_scales(S, (const float*)(WSP + WS_STATB), (LAS float*)(LDSP + RTAB_OFF), wave_s * 64 + mk_lane());
          pg8::EpiPleG<(layer < DEPTH - 1)> E{(const bf16*)HD1, layer < DEPTH - 1 ? HD0 : (bf16*)(WSP + WS_HN), (const bf16*)(WSP + WS_POUT), D, (const LAS float*)(LDSP + RTAB_OFF), (float*)(WSP + WS_STATA)};
          pg8::gemm_phase<pg8::EpiPleG<(layer < DEPTH - 1)>, pg8::StaticOrder, true, true>(LDSP + RING_OFF, g, S, E, wave_s); }
        GRID_BAR();
}
__global__ void __launch_bounds__(NTHR, 2) mega_fwd(Args a_by_value) {
    extern __shared__ __attribute__((aligned(16))) unsigned char lds_raw[];
    const CAS Args* ap;
    const int wave_s = __builtin_amdgcn_readfirstlane((int)threadIdx.x >> 6);
    { IDS(); for (int u = tid; u < (LDS_BYTES - LDSCTL_OFF) / 4; u += NTHR) ((LAS unsigned*)(LDSP + LDSCTL_OFF))[u] = 0u;
      __syncthreads();
      LAUNDER(); (void)xcd_barrier_post((unsigned*)(WSP + WS_CTL) + CW_BAR, (volatile LAS unsigned*)(LDSP + MISC_OFF) + 8); }

    { IDS(); LAUNDER(); prologue_phase(ap, LDSP, gw, NGW, wave, lane); }
    { IDS(); LAUNDER(); norm_phase(A_IN(0), true, A_IN(2), HD0, nullptr, 1, nullptr, nullptr, nullptr, nullptr, (float*)(WSP + WS_STATA), false, (const LAS float*)LDSP, nullptr, nullptr, gw, NGW, lane); }
    GRID_BAR();

    layer_body<0>(wave_s); layer_body<1>(wave_s); layer_body<2>(wave_s); layer_body<3>(wave_s);
    { IDS(); LAUNDER(); float* H = HOUT;
      norm_phase(WSP + WS_HN, false, A_IN(22), nullptr, H, 2, nullptr, nullptr, nullptr, nullptr, nullptr, false, (const LAS float*)LDSP, nullptr, nullptr, gw, NGW, lane);
      if (bx == 0 && tid == 0) { if (__hip_atomic_load((gu32*)(WSP + WS_CTL) + CW_BAR + XB_TMO, RLX_AGENT) != 0u) { asm volatile("s_waitcnt vmcnt(0)" ::: "memory"); H[0] = __builtin_nanf(""); } } }
}

extern "C" void kernel_launch(void* const* d_in, const int* in_sizes, int n_in, void* d_out, int out_size, void* d_ws, size_t ws_size, hipStream_t stream) {
    static int grid = 0;
    if (grid == 0) {
        if (n_in != 23 || in_sizes[0] != T * D || out_size != T * D || ws_size < WS_END) { fprintf(stderr, "kernel_launch: unexpected shapes / workspace (n_in %d, in0 %d, out %d, ws %zu < %zu); nothing launched\n", n_in, n_in > 0 ? in_sizes[0] : -1, out_size, ws_size, (size_t)WS_END); grid = -1; return; }
        int dev = 0, cus = 0, per_cu = 0;
        if (hipGetDevice(&dev) != hipSuccess || hipDeviceGetAttribute(&cus, hipDeviceAttributeMultiprocessorCount, dev) != hipSuccess) { grid = -1; return; }
        if (hipFuncSetAttribute((const void*)mega_fwd, hipFuncAttributeMaxDynamicSharedMemorySize, LDS_BYTES) != hipSuccess) { fprintf(stderr, "kernel_launch: hipFuncSetAttribute failed\n"); grid = -1; return; }
        if (hipOccupancyMaxActiveBlocksPerMultiprocessor(&per_cu, (const void*)mega_fwd, NTHR, LDS_BYTES) != hipSuccess || per_cu < 1) { fprintf(stderr, "kernel_launch: occupancy query reports %d blocks per CU; nothing launched\n", per_cu); (void)hipGetLastError(); grid = -1; return; }
        (void)hipGetLastError();
        grid = cus;
    }
    if (grid < 0) return;
    if (hipMemsetAsync((char*)d_ws + WS_CTL, 0, CTL_ZERO_BYTES, stream) != hipSuccess) return;
    Args a{};
    for (int i = 0; i < 23; ++i) a.in[i] = (const float*)d_in[i];
    a.out = (float*)d_out; a.ws = (unsigned char*)d_ws;
    hipLaunchKernelGGL(mega_fwd, dim3(grid), dim3(NTHR), LDS_BYTES, stream, a);
}
```

```cpp
#include <hip/hip_runtime.h>
#include <cstdio>
#include <cstdint>
__device__ __forceinline__ int mk_lane() { int l; asm volatile("v_mbcnt_lo_u32_b32 %0, -1, 0\n\tv_mbcnt_hi_u32_b32 %0, -1, %0" : "=v"(l)); return l; }
namespace pg8 {
#define PG8_LAS __attribute__((address_space(3)))
typedef unsigned short bf16_t;
typedef short bf16x8 __attribute__((ext_vector_type(8)));
typedef float f32x4 __attribute__((ext_vector_type(4)));
typedef unsigned u32x4 __attribute__((ext_vector_type(4)));
constexpr int BM = 256, BK = 64, HALF = 128, HTB = HALF * BK * 2  , STAGE_BYTES = 8 * HTB, NXCD = 8, WGM_DEFAULT = 4;

__host__ __device__ __forceinline__ int lds_byte(int r, int c) { const int st = (r >> 4) * 2 + (c >> 5), rr = r & 15, cc = c & 31, ob = rr * 64 + cc * 2; return st * 1024 + (ob ^ (((ob >> 9) & 1) << 5)); }
__host__ __device__ __forceinline__ void stage_rc(int b, int& R, int& C) { const int st = b / 1024, sb = b % 1024, swz = sb ^ (((sb >> 9) & 1) << 5); R = (st >> 1) * 16 + swz / 64; C = (st & 1) * 32 + (swz % 64) / 2; }
__host__ __device__ __forceinline__ int perm32(int rho) { const int n = rho >> 4, i = rho & 15; return 8 * (i >> 2) + 4 * n + (i & 3); }

struct Unit { int pm, pn, idx, koff; };
struct Gemm { const bf16_t* A; const bf16_t* Bt; int M, N, K, kloop; };

struct StaticOrder {
    static constexpr bool GATHER = false;
    int nM, nN, nwg, G, c, WGM;
    __host__ __device__ void init(int M, int N, int G_, int c_, int wgm = WGM_DEFAULT) { nM = M / BM; nN = N / BM; nwg = nM * nN; G = G_; c = c_; WGM = wgm; }
    __host__ __device__ bool next(int i, Unit& u) const {
        const long L = (long)i * G + c; if (L >= nwg) return false;
        int wgid = (int)L; { const int q = nwg / NXCD, r = nwg % NXCD, xcd = wgid % NXCD, off = wgid / NXCD; wgid = (xcd < r ? xcd * (q + 1) : r * (q + 1) + (xcd - r) * q) + off; }
        const int nig = WGM * nN, gid = wgid / nig, fm = gid * WGM, gsz = (nM - fm) < WGM ? (nM - fm) : WGM;
        u.pm = fm + ((wgid % nig) % gsz); u.pn = (wgid % nig) / gsz; u.idx = i; u.koff = 0; return true;
    }
    __device__ __forceinline__ void a_ready(const Unit&) const {}
    __device__ __forceinline__ void done(const Unit&) const {}
};

__device__ __forceinline__ unsigned cvt_pk_bf16(float lo, float hi) { unsigned r; asm volatile("v_cvt_pk_bf16_f32 %0, %1, %2" : "=v"(r) : "v"(lo), "v"(hi)); return r; }
typedef float f32x2 __attribute__((ext_vector_type(2)));
typedef unsigned u32x2 __attribute__((ext_vector_type(2)));
__device__ __forceinline__ float bf_lo(unsigned u) { return __uint_as_float(u << 16); }
__device__ __forceinline__ float bf_hi(unsigned u) { return __uint_as_float(u & 0xffff0000u); }
__device__ __forceinline__ float sigmoidf_(float x) { return __builtin_amdgcn_rcpf(1.0f + __expf(-x)); }
__device__ __forceinline__ float quad_sum(float v) { v += __int_as_float(__builtin_amdgcn_ds_swizzle(__float_as_int(v), (16 << 10) | 0x1f));
    const auto rr = __builtin_amdgcn_permlane32_swap(__float_as_uint(v), __float_as_uint(v), false, false); return __uint_as_float(rr[0]) + __uint_as_float(rr[1]); }
__device__ __forceinline__ void row_scales(const PG8_LAS float* rtab, int idx, int rloc  , float (&rs)[2][4]) {
#pragma unroll
    for (int ai = 0; ai < 2; ++ai)
#pragma unroll
        for (int m = 0; m < 4; ++m) rs[ai][m] = rtab[idx * 256 + rloc + ai * HALF + m * 16];
}
template <class Sched>
__device__ __forceinline__ void build_row_scales(const Sched& S, const float* stat, PG8_LAS float* rtab, int tid) {
    Unit u; const int r = tid & 255;
    for (int i = __builtin_amdgcn_readfirstlane(tid >> 8); S.next(i, u); i += 2) { const f32x4* p = (const f32x4*)(stat + (size_t)(u.pm * BM + r) * 16); const f32x4 a = p[0], b = p[1], c = p[2], d = p[3];
        rtab[i * 256 + r] = rsqrtf((((a[0] + a[1]) + (a[2] + a[3])) + ((b[0] + b[1]) + (b[2] + b[3])) + (((c[0] + c[1]) + (c[2] + c[3])) + ((d[0] + d[1]) + (d[2] + d[3])))) * (1.0f / 1024.0f) + 1e-6f); }
    __syncthreads();
}
template <bool SCALE> struct EpiStore {
    static constexpr bool PERM = true, AFTER_DRAIN = false;
    bf16_t* O; int ldc; int nN; const PG8_LAS float* rtab; long slab;
    __device__ __forceinline__ void operator()(const f32x4 (&acc)[2][2][4][2], const Unit& u, int wr_, int wc_, int fr_, int fq_) const {
        (void)fr_; (void)fq_; const int ln_ = mk_lane(), fr = ln_ & 15, fq = ln_ >> 4, wr = wr_, wc = wc_;
        const int row0 = u.pm * BM + wr * 64 + fr; const int col0 = (u.pn % nN) * BM + wc * 32 + 8 * fq;
        float rs[2][4]; if (SCALE) row_scales(rtab, u.idx, wr * 64 + fr, rs);
#pragma unroll
        for (int ai = 0; ai < 2; ++ai)
#pragma unroll
            for (int m = 0; m < 4; ++m) { bf16_t* rowp = O + (long)u.idx * slab + (long)(row0 + ai * HALF + m * 16) * ldc + col0; const float sc = SCALE ? rs[ai][m] : 1.0f;
#pragma unroll
                for (int bj = 0; bj < 2; ++bj) { const f32x4 v0 = acc[ai][bj][m][0] * sc, v1 = acc[ai][bj][m][1] * sc;
                    u32x4 w; w.x = cvt_pk_bf16(v0[0], v0[1]); w.y = cvt_pk_bf16(v0[2], v0[3]); w.z = cvt_pk_bf16(v1[0], v1[1]); w.w = cvt_pk_bf16(v1[2], v1[3]);
                    *(u32x4*)(rowp + bj * HALF) = w; } }
    }
};
template <bool SCALE> struct EpiSwiGLU {
    static constexpr bool PERM = true, AFTER_DRAIN = false;
    bf16_t* O; int ldc; int nN; const PG8_LAS float* rtab;
    __device__ __forceinline__ void operator()(const f32x4 (&acc)[2][2][4][2], const Unit& u, int wr_, int wc_, int fr_, int fq_) const {
        (void)fr_; (void)fq_; const int ln_ = mk_lane(), fr = ln_ & 15, fq = ln_ >> 4, wr = wr_, wc = wc_;
        const int row0 = u.pm * BM + wr * 64 + fr; const int col0 = (u.pn % nN) * HALF + wc * 32 + 8 * fq;
        float rs[2][4]; if (SCALE) row_scales(rtab, u.idx, wr * 64 + fr, rs);
#pragma unroll
        for (int ai = 0; ai < 2; ++ai)
#pragma unroll
            for (int m = 0; m < 4; ++m) { bf16_t* rowp = O + (size_t)(row0 + ai * HALF + m * 16) * ldc + col0; const float sc = SCALE ? rs[ai][m] : 1.0f;
                float r[8];
#pragma unroll
                for (int n = 0; n < 2; ++n)
#pragma unroll
                    for (int i = 0; i < 4; ++i) { const float a = acc[ai][0][m][n][i] * sc, b = acc[ai][1][m][n][i] * sc; r[n * 4 + i] = a * sigmoidf_(a) * b; }
                u32x4 w; w.x = cvt_pk_bf16(r[0], r[1]); w.y = cvt_pk_bf16(r[2], r[3]); w.z = cvt_pk_bf16(r[4], r[5]); w.w = cvt_pk_bf16(r[6], r[7]);
                *(u32x4*)rowp = w; }
    }
};
template <bool STATS> struct EpiResid {
    static constexpr bool PERM = true, AFTER_DRAIN = false;
    const bf16_t* base; bf16_t* out; int ldc; float* stat;
    __device__ __forceinline__ void operator()(const f32x4 (&acc)[2][2][4][2], const Unit& u, int wr_, int wc_, int fr_, int fq_) const {
        (void)fr_; (void)fq_; const int ln_ = mk_lane(), fr = ln_ & 15, fq = ln_ >> 4, wr = wr_, wc = wc_;
        const int col0 = u.pn * BM + wc * 32 + 8 * fq;
#pragma unroll
        for (int ai = 0; ai < 2; ++ai)
#pragma unroll
            for (int m = 0; m < 4; ++m) { const int row = u.pm * BM + ai * HALF + wr * 64 + m * 16 + fr; const size_t off = (size_t)row * ldc + col0; float ss = 0.f;
#pragma unroll
                for (int bj = 0; bj < 2; ++bj) { const size_t p = off + bj * HALF; const u32x4 bw = *(const u32x4*)(base + p);
                    f32x4 o0 = acc[ai][bj][m][0], o1 = acc[ai][bj][m][1];
                    o0[0] += bf_lo(bw.x); o0[1] += bf_hi(bw.x); o0[2] += bf_lo(bw.y); o0[3] += bf_hi(bw.y); o1[0] += bf_lo(bw.z); o1[1] += bf_hi(bw.z); o1[2] += bf_lo(bw.w); o1[3] += bf_hi(bw.w);
                    u32x4 w; w.x = cvt_pk_bf16(o0[0], o0[1]); w.y = cvt_pk_bf16(o0[2], o0[3]); w.z = cvt_pk_bf16(o1[0], o1[1]); w.w = cvt_pk_bf16(o1[2], o1[3]); *(u32x4*)(out + p) = w;
                    if (STATS) ss += ((o0[0] * o0[0] + o0[1] * o0[1]) + (o0[2] * o0[2] + o0[3] * o0[3])) + ((o1[0] * o1[0] + o1[1] * o1[1]) + (o1[2] * o1[2] + o1[3] * o1[3])); }
                if (STATS) { ss = quad_sum(ss); if (fq == 0) stat[(size_t)row * 16 + 4 * u.pn + wc] = ss; } }
    }
};
struct EpiPleP {
    static constexpr bool PERM = true, AFTER_DRAIN = false;
    bf16_t* P; int ldc;
    __device__ __forceinline__ void operator()(const f32x4 (&acc)[2][2][4][2], const Unit& u, int wr_, int wc_, int fr_, int fq_) const {
        (void)fr_; (void)fq_; const int ln_ = mk_lane(), fr = ln_ & 15, fq = ln_ >> 4, wr = wr_, wc = wc_;
        const int col0 = u.pn * BM + wc * 32 + 8 * fq;
#pragma unroll
        for (int ai = 0; ai < 2; ++ai)
#pragma unroll
            for (int m = 0; m < 4; ++m) { const size_t off = (size_t)(u.pm * BM + ai * HALF + wr * 64 + m * 16 + fr) * ldc + col0;
#pragma unroll
                for (int bj = 0; bj < 2; ++bj) { const f32x4 v0 = acc[ai][bj][m][0], v1 = acc[ai][bj][m][1]; u32x4 w; w.x = cvt_pk_bf16(v0[0], v0[1]); w.y = cvt_pk_bf16(v0[2], v0[3]); w.z = cvt_pk_bf16(v1[0], v1[1]); w.w = cvt_pk_bf16(v1[2], v1[3]);
                    *(u32x4*)(P + off + bj * HALF) = w; } }
    }
};
template <bool STATS> struct EpiPleG {
    static constexpr bool PERM = true, AFTER_DRAIN = false;
    const bf16_t* base; bf16_t* out; const bf16_t* P; int ldc; const PG8_LAS float* rtab; float* stat;
    __device__ __forceinline__ void operator()(const f32x4 (&acc)[2][2][4][2], const Unit& u, int wr_, int wc_, int fr_, int fq_) const {
        (void)fr_; (void)fq_; const int ln_ = mk_lane(), fr = ln_ & 15, fq = ln_ >> 4, wr = wr_, wc = wc_;
        const int col0 = u.pn * BM + wc * 32 + 8 * fq;
        float rs[2][4]; row_scales(rtab, u.idx, wr * 64 + fr, rs);
#pragma unroll
        for (int ai = 0; ai < 2; ++ai)
#pragma unroll
            for (int m = 0; m < 4; ++m) { const int row = u.pm * BM + ai * HALF + wr * 64 + m * 16 + fr; const size_t off = (size_t)row * ldc + col0; float ss = 0.f; const float sc = rs[ai][m];
#pragma unroll
                for (int bj = 0; bj < 2; ++bj) { const size_t p = off + bj * HALF; const u32x4 bw = *(const u32x4*)(base + p); const u32x4 pw = *(const u32x4*)(P + p);
                    const f32x4 a0 = acc[ai][bj][m][0] * sc, a1 = acc[ai][bj][m][1] * sc;
                    f32x4 o0, o1; o0[0] = bf_lo(bw.x) + bf_lo(pw.x) * sigmoidf_(a0[0]); o0[1] = bf_hi(bw.x) + bf_hi(pw.x) * sigmoidf_(a0[1]); o0[2] = bf_lo(bw.y) + bf_lo(pw.y) * sigmoidf_(a0[2]); o0[3] = bf_hi(bw.y) + bf_hi(pw.y) * sigmoidf_(a0[3]);
                    o1[0] = bf_lo(bw.z) + bf_lo(pw.z) * sigmoidf_(a1[0]); o1[1] = bf_hi(bw.z) + bf_hi(pw.z) * sigmoidf_(a1[1]); o1[2] = bf_lo(bw.w) + bf_lo(pw.w) * sigmoidf_(a1[2]); o1[3] = bf_hi(bw.w) + bf_hi(pw.w) * sigmoidf_(a1[3]);
                    u32x4 w; w.x = cvt_pk_bf16(o0[0], o0[1]); w.y = cvt_pk_bf16(o0[2], o0[3]); w.z = cvt_pk_bf16(o1[0], o1[1]); w.w = cvt_pk_bf16(o1[2], o1[3]); *(u32x4*)(out + p) = w;
                    if (STATS) ss += ((o0[0] * o0[0] + o0[1] * o0[1]) + (o0[2] * o0[2] + o0[3] * o0[3])) + ((o1[0] * o1[0] + o1[1] * o1[1]) + (o1[2] * o1[2] + o1[3] * o1[3])); }
                if (STATS) { ss = quad_sum(ss); if (fq == 0) stat[(size_t)row * 16 + 4 * u.pn + wc] = ss; } }
    }
};
struct TailOrder {
    static constexpr bool GATHER = false;
    int first, ntail, G, c, kq; const PG8_LAS int* tile_e;
    __device__ void init(int Mp, int first_, int kquarter, int G_, int c_, const PG8_LAS int* te) { first = first_; ntail = Mp / BM - first_; G = G_; c = c_; kq = kquarter; tile_e = te; }
    __device__ bool next(int i, Unit& u) const { const int s = i * G + c; if (s >= ntail * 16) return false; u.pm = first + (s >> 4); u.pn = ((s >> 2) & 3) + tile_e[u.pm] * 4; u.idx = s & 3; u.koff = (s & 3) * kq; return true; }
    __device__ __forceinline__ void a_ready(const Unit&) const {}
    __device__ __forceinline__ void done(const Unit&) const {}
};
template <bool GATHER_>
struct GroupedOrderT {
    static constexpr bool GATHER = GATHER_;
    StaticOrder so; int nN; const PG8_LAS int* tile_e; const unsigned* rowtok; PG8_LAS unsigned char* gtab;
    __device__ void init(int Mp, int N, int G_, int c_, const PG8_LAS int* te, int wgm = WGM_DEFAULT) { so.init(Mp, N, G_, c_, wgm); nN = N / BM; tile_e = te; rowtok = nullptr; gtab = nullptr; }
    __device__ bool next(int i, Unit& u) const { if (!so.next(i, u)) return false; u.pn += tile_e[u.pm] * nN; return true; }
    __device__ __forceinline__ void a_ready(const Unit&) const {}
    __device__ __forceinline__ void done(const Unit&) const {}
};
typedef GroupedOrderT<false> GroupedOrder;
template <class Epi, class Sched, bool ALIGN_EPI = false, bool SP2 = false>
__device__ __forceinline__ void gemm_phase(PG8_LAS unsigned char* lds, const Gemm g, const Sched& S, const Epi& E, int wave_s) {
    int tid_ = wave_s * 64 + mk_lane(); asm volatile("" : "+v"(tid_));
    const int tid = tid_, wid = __builtin_amdgcn_readfirstlane(tid >> 6), lane = tid & 63, wr = wid >> 2, wc = wid & 3, fr = lane & 15, fq = lane >> 4;
    int K_ = g.K; asm volatile("" : "+s"(K_));
    const int K = K_;
    int kl_ = g.kloop; asm volatile("" : "+s"(kl_)); const int nt = kl_ / BK;
    unsigned voffA[2], voffB[2];
#pragma unroll
    for (int i = 0; i < 2; ++i) { int R, C; stage_rc(tid * 16 + i * 8192, R, C); const int Rb = Epi::PERM ? ((R & ~31) + perm32(R & 31)) : R;
        voffA[i] = (unsigned)(R * K + C) * 2u; voffB[i] = (unsigned)(Rb * K + C) * 2u; }
    const size_t kstep = (size_t)(BK * 2);
    const size_t hstep = (size_t)HALF * K * 2;
    const size_t tstep = 2 * hstep;
    const unsigned ldsw = (unsigned)wid * 1024u;
    static_assert(!Sched::GATHER || SP2, "the gathered A staging is written for the SP2 loop");
    unsigned vg[4] = {0u, 0u, 0u, 0u}, gr0 = 0u, gC2 = 0u; const unsigned K2 = (unsigned)K * 2u;
    if constexpr (Sched::GATHER) { int R_, C_; stage_rc(tid * 16, R_, C_); gr0 = (unsigned)R_; gC2 = (unsigned)C_ * 2u; }
    (void)vg; (void)gr0; (void)gC2; (void)K2;
    const int aoff = lds_byte(wr * 64 + fr, fq * 8), boff = lds_byte(wc * 32 + fr, fq * 8);
#define PG8_SA(b, h) (((b) * 2 + (h)) * HTB)
#define PG8_SB(b, h) ((4 + (b) * 2 + (h)) * HTB)
#define PG8_STAGE(bufoff, gbase, voff) do { _Pragma("unroll") for (int _i = 0; _i < 2; ++_i) \
        __builtin_amdgcn_global_load_lds((const unsigned*)((const char*)(gbase) + (voff)[_i]), (PG8_LAS unsigned*)(lds + (bufoff) + ldsw + _i * 8192), 16, 0, 0); } while (0)
#define PG8_STAGE_A(bufoff, gbase, h) do { if constexpr (Sched::GATHER) { _Pragma("unroll") for (int _i = 0; _i < 2; ++_i) \
        __builtin_amdgcn_global_load_lds((const unsigned*)((gbase) + vg[2 * (h) + _i]), (PG8_LAS unsigned*)(lds + (bufoff) + ldsw + _i * 8192), 16, 0, 0); } \
    else PG8_STAGE(bufoff, (gbase) + (h) * hstep, voffA); } while (0)
#define PG8_TAB_DMA(u, buf) do { if (wid == 0) __builtin_amdgcn_global_load_lds((const unsigned*)(S.rowtok + (size_t)(u).pm * 256 + lane * 4), (PG8_LAS unsigned*)(S.gtab + (buf) * 1024), 16, 0, 0); } while (0)
#define PG8_TAB_READ(buf) do { const u32x4 q_ = *(const PG8_LAS u32x4*)(S.gtab + (buf) * 1024 + gr0 * 16u); _Pragma("unroll") for (int j_ = 0; j_ < 4; ++j_) vg[j_] = q_[j_] * K2 + gC2; } while (0)
#define PG8_LDA(dst, b, h) do { _Pragma("unroll") for (int m = 0; m < 4; ++m) _Pragma("unroll") for (int k = 0; k < 2; ++k) dst[m][k] = *(const PG8_LAS bf16x8*)(lds + PG8_SA(b, h) + aoff + m * 2048 + k * 1024); } while (0)
#define PG8_LDB(dst, b, h) do { _Pragma("unroll") for (int n = 0; n < 2; ++n) _Pragma("unroll") for (int k = 0; k < 2; ++k) dst[n][k] = *(const PG8_LAS bf16x8*)(lds + PG8_SB(b, h) + boff + n * 2048 + k * 1024); } while (0)
#define PG8_MMA(ai, bj, At, Bt) do { __builtin_amdgcn_s_setprio(1); _Pragma("unroll") for (int m = 0; m < 4; ++m) _Pragma("unroll") for (int n = 0; n < 2; ++n) _Pragma("unroll") for (int k = 0; k < 2; ++k) \
        acc[ai][bj][m][n] = __builtin_amdgcn_mfma_f32_16x16x32_bf16(Bt[n][k], At[m][k], acc[ai][bj][m][n], 0, 0, 0); __builtin_amdgcn_s_setprio(0); } while (0)
#define PG8_WAIT_V(n) asm volatile("s_waitcnt vmcnt(" #n ")" ::: "memory")
#define PG8_WAIT_L(n) asm volatile("s_waitcnt lgkmcnt(" #n ")" ::: "memory")
#define PG8_BAR __builtin_amdgcn_s_barrier()
#define PG8_SCHED __builtin_amdgcn_sched_barrier(0)
    Unit cur, nxt; int ui = 0;
    if (!S.next(0, cur)) return;
    f32x4 acc[2][2][4][2];
    float zf_ = 0.f; asm volatile("" : "+v"(zf_));
#pragma unroll
    for (int a = 0; a < 2; ++a)
#pragma unroll
        for (int b = 0; b < 2; ++b)
#pragma unroll
            for (int m = 0; m < 4; ++m)
#pragma unroll
                for (int n = 0; n < 2; ++n) acc[a][b][m][n] = (f32x4){zf_, zf_, zf_, zf_};
    bf16x8 At[4][2], B0[2][2], B1[2][2];
    const char* cA = (const char*)g.A + (Sched::GATHER ? (size_t)0 : (size_t)cur.pm * tstep) + (size_t)cur.koff * 2; const char* cB = (const char*)g.Bt + (size_t)cur.pn * tstep + (size_t)cur.koff * 2;
    S.a_ready(cur);
    if constexpr (Sched::GATHER) { PG8_TAB_DMA(cur, 0); PG8_WAIT_V(0); PG8_BAR; PG8_TAB_READ(0); }
    if constexpr (SP2) {
        PG8_STAGE(PG8_SB(0, 0), cB, voffB); PG8_STAGE(PG8_SB(0, 1), cB + hstep, voffB); PG8_STAGE_A(PG8_SA(0, 0), cA, 0); PG8_STAGE_A(PG8_SA(0, 1), cA, 1);
        if (wr == 1) PG8_BAR;
        PG8_WAIT_V(2); PG8_BAR;
        PG8_STAGE(PG8_SB(1, 0), cB + kstep, voffB); PG8_STAGE_A(PG8_SA(1, 0), cA + kstep, 0); PG8_STAGE(PG8_SB(1, 1), cB + hstep + kstep, voffB);
        PG8_WAIT_V(6); PG8_BAR;
    } else {
        PG8_STAGE(PG8_SB(0, 0), cB, voffB); PG8_STAGE_A(PG8_SA(0, 0), cA, 0); PG8_STAGE(PG8_SB(0, 1), cB + hstep, voffB); PG8_STAGE_A(PG8_SA(0, 1), cA, 1);
        if (wr == 1) PG8_BAR;
        PG8_WAIT_V(4); PG8_BAR;
        PG8_STAGE(PG8_SB(1, 0), cB + kstep, voffB); PG8_STAGE_A(PG8_SA(1, 0), cA + kstep, 0); PG8_STAGE(PG8_SB(1, 1), cB + hstep + kstep, voffB);
        PG8_WAIT_V(6); PG8_BAR;
    }
    for (;;) {
        const bool has_next = S.next(ui + 1, nxt);
        const char* nA = has_next ? (const char*)g.A + (Sched::GATHER ? (size_t)0 : (size_t)nxt.pm * tstep) + (size_t)nxt.koff * 2 : cA; const char* nB = has_next ? (const char*)g.Bt + (size_t)nxt.pn * tstep + (size_t)nxt.koff * 2 : cB;
        if constexpr (Sched::GATHER) { if (has_next) PG8_TAB_DMA(nxt, (ui + 1) & 1); }
        for (int t = 0; t < nt; t += 2) {
            const bool last = (t == nt - 2);
            const char* a1 = cA + (size_t)(t + 1) * kstep;
            const char* a2 = last ? nA : cA + (size_t)(t + 2) * kstep; const char* b2 = last ? nB : cB + (size_t)(t + 2) * kstep;
            const char* a3 = a2 + kstep; const char* b3 = b2 + kstep;
            if (last && has_next) S.a_ready(nxt);
            if constexpr (SP2) {
            PG8_LDB(B0, 0, 0); PG8_LDB(B1, 0, 1); PG8_SCHED; PG8_LDA(At, 0, 0); PG8_STAGE_A(PG8_SA(1, 1), a1, 1);
            if constexpr (Sched::GATHER) { if (last && has_next) PG8_TAB_READ((ui + 1) & 1); }
            PG8_WAIT_V(8); PG8_WAIT_L(0); PG8_BAR; PG8_MMA(0, 0, At, B0); PG8_MMA(0, 1, At, B1); PG8_BAR; PG8_SCHED;
            PG8_LDA(At, 0, 1); PG8_STAGE(PG8_SB(0, 0), b2, voffB); PG8_STAGE(PG8_SB(0, 1), b2 + hstep, voffB); PG8_STAGE_A(PG8_SA(0, 0), a2, 0);
            PG8_WAIT_V(8); PG8_WAIT_L(0); PG8_BAR; PG8_MMA(1, 0, At, B0); PG8_MMA(1, 1, At, B1); PG8_BAR; PG8_SCHED;
            PG8_LDB(B0, 1, 0); PG8_LDB(B1, 1, 1); PG8_SCHED; PG8_LDA(At, 1, 0); PG8_STAGE_A(PG8_SA(0, 1), a2, 1);
            PG8_WAIT_V(8); PG8_WAIT_L(0); PG8_BAR; PG8_MMA(0, 0, At, B0); PG8_MMA(0, 1, At, B1); PG8_BAR; PG8_SCHED;
            PG8_LDA(At, 1, 1); PG8_STAGE(PG8_SB(1, 0), b3, voffB); PG8_STAGE(PG8_SB(1, 1), b3 + hstep, voffB); PG8_STAGE_A(PG8_SA(1, 0), a3, 0);
            PG8_WAIT_V(8); PG8_WAIT_L(0); PG8_BAR; PG8_MMA(1, 0, At, B0); PG8_MMA(1, 1, At, B1); PG8_BAR; PG8_SCHED;
            } else {
            PG8_LDB(B0, 0, 0); PG8_SCHED; PG8_LDA(At, 0, 0); PG8_STAGE_A(PG8_SA(1, 1), a1, 1);
            PG8_WAIT_L(8); PG8_BAR; PG8_WAIT_L(0); PG8_MMA(0, 0, At, B0); PG8_BAR; PG8_SCHED;
            PG8_LDB(B1, 0, 1); PG8_STAGE(PG8_SB(0, 0), b2, voffB);
            PG8_BAR; PG8_WAIT_L(0); PG8_MMA(0, 1, At, B1); PG8_BAR;
            PG8_LDA(At, 0, 1); PG8_STAGE_A(PG8_SA(0, 0), a2, 0);
            PG8_BAR; PG8_WAIT_L(0); PG8_MMA(1, 0, At, B0); PG8_BAR; PG8_SCHED;
            PG8_STAGE(PG8_SB(0, 1), b2 + hstep, voffB);
            PG8_WAIT_V(6); PG8_BAR; PG8_MMA(1, 1, At, B1); PG8_BAR;
            PG8_LDB(B0, 1, 0); PG8_SCHED; PG8_LDA(At, 1, 0); PG8_STAGE_A(PG8_SA(0, 1), a2, 1);
            PG8_WAIT_L(8); PG8_BAR; PG8_WAIT_L(0); PG8_MMA(0, 0, At, B0); PG8_BAR; PG8_SCHED;
            PG8_LDB(B1, 1, 1); PG8_STAGE(PG8_SB(1, 0), b3, voffB);
            PG8_BAR; PG8_WAIT_L(0); PG8_MMA(0, 1, At, B1); PG8_BAR;
            PG8_LDA(At, 1, 1); PG8_STAGE_A(PG8_SA(1, 0), a3, 0);
            PG8_BAR; PG8_WAIT_L(0); PG8_MMA(1, 0, At, B0); PG8_BAR; PG8_SCHED;
            PG8_STAGE(PG8_SB(1, 1), b3 + hstep, voffB);
            PG8_WAIT_V(6); PG8_BAR; PG8_MMA(1, 1, At, B1); PG8_BAR;
            }
        }
        if constexpr (ALIGN_EPI) { if (wr == 0) PG8_BAR; }
        if constexpr (!Epi::AFTER_DRAIN) { E(acc, cur, wr, wc, fr, fq); S.done(cur); }
        if (!has_next) break;
        zf_ = 0.f; asm volatile("" : "+v"(zf_));
#pragma unroll
        for (int a = 0; a < 2; ++a)
#pragma unroll
            for (int b = 0; b < 2; ++b)
#pragma unroll
                for (int m = 0; m < 4; ++m)
#pragma unroll
                    for (int n = 0; n < 2; ++n) acc[a][b][m][n] = (f32x4){zf_, zf_, zf_, zf_};
        cur = nxt; cA = nA; cB = nB; ++ui;
        if constexpr (ALIGN_EPI) { if (wr == 1) PG8_BAR; }
    }
    PG8_WAIT_V(0);
    if constexpr (!ALIGN_EPI) { if (wr == 0) PG8_BAR; }
    PG8_BAR;
    if constexpr (Epi::AFTER_DRAIN) { E.fused(acc, cur, wr, wc, fr, fq, lds, wid, lane); S.done(cur); }
#undef PG8_SA
#undef PG8_SB
#undef PG8_STAGE
#undef PG8_STAGE_A
#undef PG8_TAB_DMA
#undef PG8_TAB_READ
#undef PG8_LDA
#undef PG8_LDB
#undef PG8_MMA
#undef PG8_WAIT_V
#undef PG8_WAIT_L
#undef PG8_BAR
#undef PG8_SCHED
}
}
constexpr int NWAVES = 8, NTHR = NWAVES * 64;
constexpr int NB = 8, SEQ = 4096, T = NB * SEQ, D = 1024, DEPTH = 4;
constexpr int DIN = 3468, DINP = 3584;
constexpr int C_GQ = 0, C_GK = 384, C_GV = 768, C_GZ = 1152, C_DQ = 1536, C_DK = 1920, C_DV = 2304, C_SQ = 2688, C_SK = 2944, C_SV = 3200, C_GA = 3456, C_GB = 3462;
constexpr int DFF = 2816, MFF = 3584, NE = 8, PLE = 256;
constexpr int MROWS = 2 * T + 2048;
constexpr float EPS = 1e-6f;
constexpr size_t MiB = 1u << 20;
constexpr size_t WS_CTL = 0, CTL_ZERO_BYTES = 1 * MiB;
constexpr size_t WS_WIN = 1 * MiB;
constexpr size_t WS_WOUT = 29 * MiB;
constexpr size_t WS_WGATE = 37 * MiB;
constexpr size_t WS_WPROJ = 45 * MiB;
constexpr size_t WS_WF13 = 47 * MiB;
constexpr size_t WS_WF2 = 69 * MiB;
constexpr size_t WS_WM13 = 80 * MiB;
constexpr size_t WS_WM2 = 304 * MiB;
constexpr size_t WS_HN = 416 * MiB;
constexpr size_t WS_U = 480 * MiB;
constexpr size_t WS_PROJ = WS_U;
constexpr size_t WS_OMIX = WS_U + 224 * MiB;
constexpr size_t WS_GDN = WS_U + 288 * MiB;
constexpr size_t WS_DSW = WS_U + 448 * MiB;
constexpr size_t WS_ACT = WS_U;
constexpr size_t WS_ASORT = WS_U;
constexpr size_t WS_MACT = WS_U + 132 * MiB;
constexpr size_t WS_POUT = WS_U + 132 * MiB;
constexpr size_t WS_PB = WS_U + 196 * MiB;
constexpr size_t WS_ROUTE = 1074 * MiB;
constexpr size_t WS_STATA = 1075 * MiB;
constexpr size_t WS_STATB = 1077 * MiB;
constexpr size_t WS_END = 1079 * MiB;
static_assert(WS_MACT + (size_t)MROWS * MFF * 2 <= WS_ROUTE && WS_ASORT + (size_t)MROWS * D * 2 <= WS_MACT, "d_ws map");
constexpr int CW_BAR = 4096;
constexpr int RING_OFF = 0, RING_BYTES = 131072;
constexpr int LDSCTL_OFF = RING_BYTES, MISC_OFF = LDSCTL_OFF + 320;
constexpr int TILEE_OFF = LDSCTL_OFF + 1024;
constexpr int RTAB_OFF = LDSCTL_OFF + 4096;
constexpr int LDS_BYTES = 147456;
#define GAS __attribute__((address_space(1)))
#define LAS __attribute__((address_space(3)))
typedef unsigned short bf16;
typedef unsigned v4u __attribute__((ext_vector_type(4)));
typedef float f32x4 __attribute__((ext_vector_type(4)));
typedef short bf16x8 __attribute__((ext_vector_type(8)));
typedef GAS unsigned gu32;
typedef GAS unsigned long long gu64;
#define RLX_AGENT __ATOMIC_RELAXED, __HIP_MEMORY_SCOPE_AGENT
#define LDS_WAIT() asm volatile("s_waitcnt lgkmcnt(0)" ::: "memory")
#define VM_WAIT() asm volatile("s_waitcnt vmcnt(0)" ::: "memory")
__device__ __forceinline__ unsigned long long rt() { return __builtin_amdgcn_s_memrealtime(); }
__device__ __forceinline__ unsigned f2bf(float f) { unsigned u = __builtin_bit_cast(unsigned, f); return (u + 0x7fffu + ((u >> 16) & 1u)) >> 16; }
__device__ __forceinline__ unsigned pk2(float lo, float hi) { return f2bf(lo) | (f2bf(hi) << 16); }

#define XB_TMO      128
#define XB_XCNT(j)  (256  + 64 * (j))
#define XB_XSUB(j)  (1280 + 64 * (j))
#define XB_XGEN(j)  (2304 + 64 * (j))
#define XB_TOP      3328
#define XB_TOPGEN   3392
#define XCD_BAR_WORDS 3456
#define XB_SPIN_CAP (1u << 22)

__device__ __forceinline__ unsigned xb_ld(unsigned* p)              { return __hip_atomic_load(p, __ATOMIC_RELAXED, __HIP_MEMORY_SCOPE_AGENT); }
__device__ __forceinline__ unsigned xb_add(unsigned* p, unsigned v) { return __hip_atomic_fetch_add(p, v, __ATOMIC_RELAXED, __HIP_MEMORY_SCOPE_AGENT); }
__device__ __forceinline__ unsigned xb_xcc_id() { return (unsigned)__builtin_amdgcn_s_getreg((3 << 11) | 20) & 0xFu; }
#define XB_SPIN(cond, bar) do { unsigned _sp = 0; while (cond) { __builtin_amdgcn_s_sleep(1); \
    if ((++_sp & 255u) == 0u) { if (xb_ld(&(bar)[XB_TMO])) break; if (_sp > XB_SPIN_CAP) { atomicAdd(&(bar)[XB_TMO], 1u); break; } } } } while (0)

struct XcdBarrier {
    unsigned* bar; unsigned x;
    volatile LAS unsigned* st;
};

__device__ __forceinline__ XcdBarrier xcd_barrier_post(unsigned* bar, volatile LAS unsigned* st) {
    XcdBarrier b; b.bar = bar; b.x = xb_xcc_id(); b.st = st;
    if (threadIdx.x == 0) (void)xb_add(&bar[XB_XCNT(b.x)], 1u);
    return b;
}
__device__ __forceinline__ void xcd_barrier_complete(unsigned* bar, unsigned x, unsigned& nloc, unsigned& nx) {
    const unsigned G = gridDim.x * gridDim.y * gridDim.z;
    unsigned sum, cnt, mine, sp = 0u;
    for (;;) {
        sum = 0u; cnt = 0u; mine = 0u;
#pragma unroll
        for (unsigned j = 0; j < 16; ++j) { const unsigned c = xb_ld(&bar[XB_XCNT(j)]); sum += c; cnt += (c > 0u) ? 1u : 0u; mine = (j == x) ? c : mine; }
        if (sum == G) break;
        __builtin_amdgcn_s_sleep(1);
        if ((++sp & 255u) == 0u) { if (xb_ld(&bar[XB_TMO])) break; if (sp > XB_SPIN_CAP) { atomicAdd(&bar[XB_TMO], 1u); break; } }
    }
    nloc = mine > 0u ? mine : 1u; nx = cnt > 0u ? cnt : 1u;
}

__device__ __forceinline__ void xcd_barrier(const XcdBarrier& b) {
    asm volatile("s_waitcnt vmcnt(0)" ::: "memory");
    __syncthreads();
    if (threadIdx.x == 0) {
        unsigned* bar = b.bar;
        __builtin_amdgcn_s_waitcnt(0);
        unsigned nloc = b.st[0], nx = b.st[1];
        if (nloc == 0u) { xcd_barrier_complete(bar, b.x, nloc, nx); b.st[0] = nloc; b.st[1] = nx; }
        const unsigned old = xb_add(&bar[XB_XSUB(b.x)], 1u);
        const unsigned gen = old / nloc;
        if (old + 1u == (gen + 1u) * nloc) {
            __builtin_amdgcn_fence(__ATOMIC_RELEASE, "agent");
            asm volatile("s_waitcnt vmcnt(0)" ::: "memory");
            const unsigned og = xb_add(&bar[XB_TOP], 1u);
            const unsigned tg = og / nx;
            if (og + 1u == (tg + 1u) * nx) xb_add(&bar[XB_TOPGEN], 1u);
            else XB_SPIN(xb_ld(&bar[XB_TOPGEN]) == tg, bar);
            __builtin_amdgcn_fence(__ATOMIC_ACQUIRE, "agent");
            xb_add(&bar[XB_XGEN(b.x)], 1u);
            asm volatile("s_waitcnt vmcnt(0)" ::: "memory");
        } else {
            { const unsigned ai = old - gen * nloc + 1u;
              if (ai == nloc / 4u || ai == nloc / 2u || ai == (3u * nloc) / 4u || ai == (7u * nloc) / 8u) asm volatile("buffer_wbl2 sc1" ::: "memory"); }
            XB_SPIN(xb_ld(&bar[XB_XGEN(b.x)]) == gen, bar);
            __builtin_amdgcn_fence(__ATOMIC_ACQUIRE, "agent");
            asm volatile("s_waitcnt vmcnt(0)" ::: "memory");
        }
    }
    __syncthreads();
}
typedef unsigned u32x2 __attribute__((ext_vector_type(2)));
__device__ __forceinline__ float bf2f(bf16 u) { return __uint_as_float((unsigned)u << 16); }
__device__ __forceinline__ float bflo(unsigned u) { return __uint_as_float(u << 16); }
__device__ __forceinline__ float bfhi(unsigned u) { return __uint_as_float(u & 0xffff0000u); }
#define SWZ_XOR(v, k) __int_as_float(__builtin_amdgcn_ds_swizzle(__float_as_int(v), ((k) << 10) | 0x1f))
__device__ __forceinline__ float wave_sum(float v) {
    v += SWZ_XOR(v, 1); v += SWZ_XOR(v, 2); v += SWZ_XOR(v, 4); v += SWZ_XOR(v, 8); v += SWZ_XOR(v, 16);
    const auto rr = __builtin_amdgcn_permlane32_swap(__float_as_uint(v), __float_as_uint(v), false, false);
    return __uint_as_float(rr[0]) + __uint_as_float(rr[1]);
}
__device__ __forceinline__ float wave_max(float v) {
    v = fmaxf(v, SWZ_XOR(v, 1)); v = fmaxf(v, SWZ_XOR(v, 2)); v = fmaxf(v, SWZ_XOR(v, 4)); v = fmaxf(v, SWZ_XOR(v, 8)); v = fmaxf(v, SWZ_XOR(v, 16));
    const auto rr = __builtin_amdgcn_permlane32_swap(__float_as_uint(v), __float_as_uint(v), false, false);
    return fmaxf(__uint_as_float(rr[0]), __uint_as_float(rr[1]));
}
__device__ __forceinline__ float silu_f(float x) { return x * __builtin_amdgcn_rcpf(1.0f + __expf(-x)); }
__device__ __forceinline__ float sigm_f(float x) { return __builtin_amdgcn_rcpf(1.0f + __expf(-x)); }
__device__ __forceinline__ float softplus_f(float x) { const float e = __expf(-fabsf(x));
    const float l = e < 0.02f ? e * (1.0f - e * (0.5f - e * (0.33333334f - 0.25f * e))) : __logf(1.0f + e); return fmaxf(x, 0.f) + l; }
__device__ __forceinline__ float rdlane(float v, int l) { return __int_as_float(__builtin_amdgcn_readlane(__float_as_int(v), l)); }

#define CAS __attribute__((address_space(4)))
struct Args { const float* in[23]; float* out; unsigned char* ws; };

struct MapIn { const float* W; const float* nw;
    __device__ __forceinline__ float operator()(int k, int n) const { const int o = n < 1536 ? n : (n < 3456 ? n + 12 : (n < 3468 ? 1536 + (n - 3456) : -1)); return o >= 0 ? W[(size_t)k * DIN + o] * nw[k] : 0.f; } };
struct MapPlain { const float* W; int N;
    __device__ __forceinline__ float operator()(int k, int n) const { return W[(size_t)k * N + n]; } };
struct MapScaled { const float* W; int N; const float* nw;
    __device__ __forceinline__ float operator()(int k, int n) const { return W[(size_t)k * N + n] * nw[k]; } };
template <class Map>
__device__ __forceinline__ void tr_item(const Map& map, int K, bf16* WT, LAS float* scr, int kb, int nb, int lane, int drow0 = -1) {
    const int k0 = 64 * kb, n0 = 32 * nb; const int d0 = drow0 < 0 ? n0 : drow0;
#pragma unroll 8
    for (int i = 0; i < 32; ++i) { const int kk = 2 * i + (lane >> 5); scr[kk * 33 + (lane & 31)] = map(k0 + kk, n0 + (lane & 31)); }
    LDS_WAIT(); asm volatile("" ::: "memory");
    const int c = lane & 7;
#pragma unroll
    for (int j = 0; j < 4; ++j) { const int n = (lane >> 3) + 8 * j; const LAS float* s = scr + (8 * c) * 33 + n;
        v4u o; o.x = pk2(s[0 * 33], s[1 * 33]); o.y = pk2(s[2 * 33], s[3 * 33]); o.z = pk2(s[4 * 33], s[5 * 33]); o.w = pk2(s[6 * 33], s[7 * 33]);
        *(GAS v4u*)(WT + (size_t)(d0 + n) * K + k0 + 8 * c) = o; }
    LDS_WAIT(); asm volatile("" ::: "memory");
}
__device__ __forceinline__ void prologue_phase(const CAS Args* a, LAS unsigned char* lds, int gw, int NGW, int wave, int lane) {
    LAS float* scr = (LAS float*)(lds + RING_OFF + wave * 16384);
    constexpr int I_IN = 16 * (DINP / 32), I_OUT = 16 * 32, I_GATE = 16 * 32, I_PROJ = 4 * 32, I_L = I_IN + I_OUT + I_GATE + I_PROJ;
    constexpr int I_F13 = 16 * (2 * DFF / 32), I_F2 = (DFF / 64) * 32, I_F = I_F13 + I_F2;
    constexpr int I_M13 = 16 * (2 * MFF / 32), I_M2 = (MFF / 64) * 32, I_M = I_M13 + I_M2;
    constexpr int NITEMS = 4 * I_L + 2 * I_F + 16 * I_M;
    unsigned char* ws = (unsigned char*)a->ws;
    for (int it0 = gw; it0 < NITEMS; it0 += NGW) {
        int it = it0;
        if (it < 4 * I_L) { const int l = it / I_L; int r = it % I_L;
            if (r < I_IN) { MapIn m{a->in[3] + (size_t)l * D * DIN, a->in[2] + l * D}; tr_item(m, D, (bf16*)(ws + WS_WIN) + (size_t)l * DINP * D, scr, r / (DINP / 32), r % (DINP / 32), lane); continue; } r -= I_IN;
            if (r < I_OUT) { MapPlain m{a->in[10] + (size_t)l * D * D, D}; tr_item(m, D, (bf16*)(ws + WS_WOUT) + (size_t)l * D * D, scr, r / 32, r % 32, lane); continue; } r -= I_OUT;
            if (r < I_GATE) { MapScaled m{a->in[21] + (size_t)l * D * D, D, a->in[20] + l * D}; tr_item(m, D, (bf16*)(ws + WS_WGATE) + (size_t)l * D * D, scr, r / 32, r % 32, lane); continue; } r -= I_GATE;
            { MapPlain m{a->in[19] + (size_t)l * PLE * D, D}; tr_item(m, PLE, (bf16*)(ws + WS_WPROJ) + (size_t)l * D * PLE, scr, r / 32, r % 32, lane); continue; }
        }
        it -= 4 * I_L;
        if (it < 2 * I_F) { const int j = it / I_F; int r = it % I_F;
            if (r < I_F13) { const int half = r / (I_F13 / 2), rr = r % (I_F13 / 2), kb = rr / (DFF / 32), nb = rr % (DFF / 32);
                MapScaled m{a->in[12 + half] + (size_t)j * D * DFF, DFF, a->in[11] + 2 * j * D}; tr_item(m, D, (bf16*)(ws + WS_WF13) + (size_t)j * 2 * DFF * D, scr, kb, nb, lane, ((32 * nb) >> 7) * 256 + ((32 * nb) & 127) + 128 * half); continue; } r -= I_F13;
            { MapPlain m{a->in[14] + (size_t)j * DFF * D, D}; tr_item(m, DFF, (bf16*)(ws + WS_WF2) + (size_t)j * D * DFF, scr, r / 32, r % 32, lane); continue; }
        }
        it -= 2 * I_F;
        { const int je = it / I_M; int r = it % I_M;
            if (r < I_M13) { const int half = r / (I_M13 / 2), rr = r % (I_M13 / 2), kb = rr / (MFF / 32), nb = rr % (MFF / 32);
                MapPlain m{a->in[16 + half] + (size_t)je * D * MFF, MFF}; tr_item(m, D, (bf16*)(ws + WS_WM13) + (size_t)je * 2 * MFF * D, scr, kb, nb, lane, ((32 * nb) >> 7) * 256 + ((32 * nb) & 127) + 128 * half); continue; } r -= I_M13;
            { MapPlain m{a->in[18] + (size_t)je * MFF * D, D}; tr_item(m, MFF, (bf16*)(ws + WS_WM2) + (size_t)je * D * MFF, scr, r / 32, r % 32, lane); }
        }
    }
}

__device__ __forceinline__ void norm_phase(const void* hin, bool in_f32, const float* w, bf16* hn, float* outf, int mode,
                                           const bf16* ysort, const bf16* ypart, const int* pos, const float* gate, float* stat,
                                           bool do_route, const LAS float* rlds, int* tok_e, float* tok_g,
                                           int gw, int NGW, int lane) {
    f32x4 wv[4];
#pragma unroll
    for (int j = 0; j < 4; ++j) wv[j] = *(const f32x4*)(w + 4 * lane + 256 * j);
    for (int m = gw; m < T; m += NGW) {
        f32x4 v[4];
        if (in_f32) { const float* xr = (const float*)hin + (size_t)m * D + 4 * lane;
#pragma unroll
            for (int j = 0; j < 4; ++j) v[j] = *(const f32x4*)(xr + 256 * j); }
        else { const bf16* xr = (const bf16*)hin + (size_t)m * D + 4 * lane;
#pragma unroll
            for (int j = 0; j < 4; ++j) { const u32x2 a = *(const u32x2*)(xr + 256 * j); v[j] = (f32x4){bflo(a.x), bfhi(a.x), bflo(a.y), bfhi(a.y)}; } }
        if (ysort) {
            const int p1 = pos[2 * m], p2 = pos[2 * m + 1]; const float g1 = gate[2 * m], g2 = gate[2 * m + 1];
#pragma unroll
            for (int c2 = 0; c2 < 2; ++c2) { const int p = c2 ? p2 : p1; const float g = c2 ? g2 : g1;
                if (p < 2 * T) { const bf16* y = ysort + (size_t)p * D + 4 * lane;
#pragma unroll
                    for (int j = 0; j < 4; ++j) { const u32x2 a = *(const u32x2*)(y + 256 * j); v[j][0] += g * bflo(a.x); v[j][1] += g * bfhi(a.x); v[j][2] += g * bflo(a.y); v[j][3] += g * bfhi(a.y); } }
                else {
#pragma unroll
                    for (int ks = 0; ks < 4; ++ks) { const bf16* y = ypart + ((size_t)ks * 2048 + (p - 2 * T)) * D + 4 * lane;
#pragma unroll
                        for (int j = 0; j < 4; ++j) { const u32x2 a = *(const u32x2*)(y + 256 * j); v[j][0] += g * bflo(a.x); v[j][1] += g * bfhi(a.x); v[j][2] += g * bflo(a.y); v[j][3] += g * bfhi(a.y); } } } }
        }
        float s = 0.f;
#pragma unroll
        for (int j = 0; j < 4; ++j) s += (v[j][0] * v[j][0] + v[j][1] * v[j][1]) + (v[j][2] * v[j][2] + v[j][3] * v[j][3]);
        const float ssum = wave_sum(s); const float r = mode == 1 ? 1.0f : rsqrtf(ssum * (1.0f / D) + EPS);
        if (mode == 1) { if (lane < 16) stat[(size_t)m * 16 + lane] = lane == 0 ? ssum : 0.f; }
#pragma unroll
        for (int j = 0; j < 4; ++j) if (mode != 1) v[j] = v[j] * r * wv[j];
        if (mode == 2) { float* orow = outf + (size_t)m * D + 4 * lane;
#pragma unroll
            for (int j = 0; j < 4; ++j) *(f32x4*)(orow + 256 * j) = v[j]; }
        else { bf16* orow = hn + (size_t)m * D + 4 * lane;
#pragma unroll
            for (int j = 0; j < 4; ++j) { u32x2 o; o.x = pk2(v[j][0], v[j][1]); o.y = pk2(v[j][2], v[j][3]); *(u32x2*)(orow + 256 * j) = o; } }
        if (do_route) {
            float lg[8];
#pragma unroll
            for (int e = 0; e < 8; ++e) lg[e] = 0.f;
#pragma unroll
            for (int j = 0; j < 4; ++j)
#pragma unroll
                for (int i = 0; i < 4; ++i) { const LAS f32x4* rp = (const LAS f32x4*)(rlds + (size_t)(4 * lane + 256 * j + i) * 8); const f32x4 r0 = rp[0], r1 = rp[1]; const float y = v[j][i];
                    lg[0] += y * r0[0]; lg[1] += y * r0[1]; lg[2] += y * r0[2]; lg[3] += y * r0[3]; lg[4] += y * r1[0]; lg[5] += y * r1[1]; lg[6] += y * r1[2]; lg[7] += y * r1[3]; }
#pragma unroll
            for (int e = 0; e < 8; ++e) lg[e] = wave_sum(lg[e]);
            int i1 = 0; float v1 = lg[0];
#pragma unroll
            for (int e = 1; e < 8; ++e) if (lg[e] > v1) { v1 = lg[e]; i1 = e; }
            int i2 = -1; float v2 = -3.0e38f;
#pragma unroll
            for (int e = 0; e < 8; ++e) if (e != i1 && lg[e] > v2) { v2 = lg[e]; i2 = e; }
            const float g1 = 1.0f / (1.0f + __expf(v2 - v1));
            if (lane == 0) { tok_e[m] = i1 | (i2 << 8); tok_g[2 * m] = g1; tok_g[2 * m + 1] = 1.0f - g1; }
        }
    }
}

__device__ __forceinline__ void moe_gather_phase(const int* tok_e, int* pos, const bf16* hn, bf16* asort, LAS unsigned char* lds, int gw, int NGW, int wave, int lane, int tid) {
    typedef unsigned long long u64;
    LAS u64* sc = (LAS u64*)(lds + RING_OFF);
    LAS int* tab = (LAS int*)(lds + TILEE_OFF);
    { const v4u* tp = (const v4u*)(tok_e + tid * 64); u64 lo = 0ull, hi = 0ull;
#pragma unroll 4
      for (int i = 0; i < 16; ++i) { const v4u q = tp[i]; const unsigned ev[4] = {q.x, q.y, q.z, q.w};
#pragma unroll
          for (int k = 0; k < 4; ++k) { const unsigned e1 = ev[k] & 7u, e2 = (ev[k] >> 8) & 7u;
              lo += (e1 < 4u ? 1ull << (16u * e1) : 0ull) + (e2 < 4u ? 1ull << (16u * e2) : 0ull); hi += (e1 >= 4u ? 1ull << (16u * (e1 - 4u)) : 0ull) + (e2 >= 4u ? 1ull << (16u * (e2 - 4u)) : 0ull); } }
      sc[2 * tid] = lo; sc[2 * tid + 1] = hi; }
    __syncthreads();
    for (int off = 1; off < 512; off <<= 1) {
        u64 a = 0ull, b = 0ull; if (tid >= off) { a = sc[2 * (tid - off)]; b = sc[2 * (tid - off) + 1]; }
        __syncthreads();
        if (tid >= off) { sc[2 * tid] += a; sc[2 * tid + 1] += b; }
        __syncthreads(); }
    if (tid == 0) { const u64 tl = sc[2 * 511], th = sc[2 * 511 + 1]; int off = 0;
        for (int e = 0; e < 8; ++e) { const int tot = (int)(((e < 4 ? tl : th) >> (16 * (e & 3))) & 0xffffull); tab[320 + e] = tot; tab[304 + e] = off; const int np = (tot + 255) >> 8; for (int i = 0; i < np; ++i) ((volatile LAS int*)tab)[(off >> 8) + i] = e; off += np << 8; }
        tab[312] = off; tab[300] = off; }
    __syncthreads();
    for (int u = gw; u < 2048; u += NGW) { const int g = u >> 2, c = (u >> 1) & 1, hf = u & 1; const int t = g * 64 + lane; const int ev = tok_e[t]; const int e1 = ev & 7, e2 = (ev >> 8) & 7; const int em = c ? e2 : e1;
        int rank = 0; const unsigned long long lt = (1ull << lane) - 1ull;
#pragma unroll
        for (int e = 0; e < 8; ++e) { const unsigned long long mk = __ballot(e1 == e || e2 == e); if (em == e) rank = __popcll(mk & lt); }
        int pre = 0; if (g > 0) { const u64 w = sc[2 * (g - 1) + (em >> 2)]; pre = (int)((w >> (16 * (em & 3))) & 0xffffull); }
        const int slot = tab[304 + em] + pre + rank;
        if (hf == 0) pos[2 * t + c] = slot;
        for (int i0 = 32 * hf; i0 < 32 * hf + 32; i0 += 8) {
            v4u x0[8], x1[8];
#pragma unroll
            for (int i = 0; i < 8; ++i) { const v4u* src = (const v4u*)(hn + (size_t)(g * 64 + i0 + i) * D); x0[i] = src[lane]; x1[i] = src[64 + lane]; }
#pragma unroll
            for (int i = 0; i < 8; ++i) { const int dst = __builtin_amdgcn_readlane(slot, i0 + i); v4u* d = (v4u*)(asort + (size_t)dst * D); d[lane] = x0[i]; d[64 + lane] = x1[i]; } } }
    for (int e = 0; e < 8; ++e) { const int r0 = tab[304 + e] + tab[320 + e], r1 = tab[305 + e];
        for (int r = r0 + gw; r < r1; r += NGW) { v4u* d = (v4u*)(asort + (size_t)r * D); unsigned z0 = 0u; asm volatile("" : "+v"(z0)); const v4u z = {z0, z0, z0, z0}; d[lane] = z; d[64 + lane] = z; } }
}
__device__ __forceinline__ void moe_slot_phase(const int* tok_e, int* pos, unsigned* rowtok, LAS unsigned char* lds, int gw, int NGW, int wave, int lane, int tid) {
    typedef unsigned long long u64;
    LAS u64* sc = (LAS u64*)(lds + RING_OFF);
    LAS int* tab = (LAS int*)(lds + TILEE_OFF);
    { const v4u* tp = (const v4u*)(tok_e + tid * 64); u64 lo = 0ull, hi = 0ull;
#pragma unroll 4
      for (int i = 0; i < 16; ++i) { const v4u q = tp[i]; const unsigned ev[4] = {q.x, q.y, q.z, q.w};
#pragma unroll
          for (int k = 0; k < 4; ++k) { const unsigned e1 = ev[k] & 7u, e2 = (ev[k] >> 8) & 7u;
              lo += (e1 < 4u ? 1ull << (16u * e1) : 0ull) + (e2 < 4u ? 1ull << (16u * e2) : 0ull); hi += (e1 >= 4u ? 1ull << (16u * (e1 - 4u)) : 0ull) + (e2 >= 4u ? 1ull << (16u * (e2 - 4u)) : 0ull); } }
      sc[2 * tid] = lo; sc[2 * tid + 1] = hi; }
    __syncthreads();
    for (int off = 1; off < 512; off <<= 1) {
        u64 a = 0ull, b = 0ull; if (tid >= off) { a = sc[2 * (tid - off)]; b = sc[2 * (tid - off) + 1]; }
        __syncthreads();
        if (tid >= off) { sc[2 * tid] += a; sc[2 * tid + 1] += b; }
        __syncthreads(); }
    if (tid == 0) { const u64 tl = sc[2 * 511], th = sc[2 * 511 + 1]; int off = 0;
        for (int e = 0; e < 8; ++e) { const int tot = (int)(((e < 4 ? tl : th) >> (16 * (e & 3))) & 0xffffull); tab[320 + e] = tot; tab[304 + e] = off; const int np = (tot + 255) >> 8; for (int i = 0; i < np; ++i) ((volatile LAS int*)tab)[(off >> 8) + i] = e; off += np << 8; }
        tab[312] = off; tab[300] = off; }
    __syncthreads();
    for (int u = gw; u < 1024; u += NGW) { const int g = u >> 1, c = u & 1; const int t = g * 64 + lane; const int ev = tok_e[t]; const int e1 = ev & 7, e2 = (ev >> 8) & 7; const int em = c ? e2 : e1;
        int rank = 0; const unsigned long long lt = (1ull << lane) - 1ull;
#pragma unroll
        for (int e = 0; e < 8; ++e) { const unsigned long long mk = __ballot(e1 == e || e2 == e); if (em == e) rank = __popcll(mk & lt); }
        int pre = 0; if (g > 0) { const u64 w = sc[2 * (g - 1) + (em >> 2)]; pre = (int)((w >> (16 * (em & 3))) & 0xffffull); }
        const int slot = tab[304 + em] + pre + rank;
        pos[2 * t + c] = slot;
        rowtok[(slot & ~255) + ((slot & 63) << 2) + ((slot >> 6) & 3)] = (unsigned)t; }
    for (int e = 0; e < 8; ++e) { const int r0 = tab[304 + e] + tab[320 + e], r1 = tab[305 + e];
        for (int r = r0 + gw * 64 + lane; r < r1; r += NGW * 64) rowtok[(r & ~255) + ((r & 63) << 2) + ((r >> 6) & 3)] = 0u; }
}
typedef float f32x16 __attribute__((ext_vector_type(16)));
typedef short v4i16_t __attribute__((ext_vector_type(4)));
__device__ __forceinline__ int crow(int r, int hi) { return (r & 3) + 8 * (r >> 2) + 4 * hi; }
typedef float f32x2_t __attribute__((ext_vector_type(2))); typedef __bf16 bf16x2_t __attribute__((ext_vector_type(2)));
__device__ __forceinline__ unsigned cvtpk(float lo, float hi) { const f32x2_t v = {lo, hi}; const bf16x2_t b = __builtin_convertvector(v, bf16x2_t); return __builtin_bit_cast(unsigned, b); }
__device__ __forceinline__ bf16x8 mk8(unsigned a, unsigned b, unsigned c, unsigned d) { const v4u w = {a, b, c, d}; return __builtin_bit_cast(bf16x8, w); }
__device__ __forceinline__ bf16x8 pack8(const float* x) { return mk8(cvtpk(x[0], x[1]), cvtpk(x[2], x[3]), cvtpk(x[4], x[5]), cvtpk(x[6], x[7])); }
__device__ __forceinline__ bf16x8 tr_frag(const LAS unsigned char* tile, int stride, int row0, int col0, int lane) {
    const LAS unsigned char* p = tile + (row0 + ((lane & 15) >> 2)) * stride + (col0 + 4 * (lane & 3)) * 2;
    const v4i16_t a = __builtin_amdgcn_ds_read_tr16_b64_v4i16((LAS v4i16_t*)p);
    const v4i16_t b = __builtin_amdgcn_ds_read_tr16_b64_v4i16((LAS v4i16_t*)(p + 8 * stride));
    return (bf16x8){a[0], a[1], a[2], a[3], b[0], b[1], b[2], b[3]};
}
__device__ __forceinline__ float half_bcast_lo(float x) { const auto rr = __builtin_amdgcn_permlane32_swap(__float_as_uint(x), __float_as_uint(x), false, false); return __uint_as_float(rr[0]); }
__device__ __forceinline__ float half_sum(float x) { const auto rr = __builtin_amdgcn_permlane32_swap(__float_as_uint(x), __float_as_uint(x), false, false); return __uint_as_float(rr[0]) + __uint_as_float(rr[1]); }
__device__ __forceinline__ float half_max(float x) { const auto rr = __builtin_amdgcn_permlane32_swap(__float_as_uint(x), __float_as_uint(x), false, false); return fmaxf(__uint_as_float(rr[0]), __uint_as_float(rr[1])); }

constexpr int SB_STRIDE = 144, SB_WBYTES = 2 * 32 * SB_STRIDE;
constexpr float SB_EXIT = 48.0f;
__device__ __forceinline__ void sb_wave_unit(int u, int layer, const float* sbnw, const bf16* PROJ, bf16* OMIX, LAS unsigned char* wl, int lane) {
    const int bh = u >> 7, b = bh >> 2, h = bh & 3, tq0 = (u & 127) * 32, n = lane & 31, hh = lane >> 5;
    const bf16* base = PROJ + (size_t)(b * SEQ) * DINP;
    constexpr float SC = 0.125f * 1.4426950408889634f;
    bf16x8 qf[4];
    { const bf16* qp = base + (size_t)(tq0 + n) * DINP + C_SQ + h * 64 + 8 * hh;
#pragma unroll
      for (int ks = 0; ks < 4; ++ks) qf[ks] = *(const bf16x8*)(qp + 16 * ks); }
    bf16x8 ut[2];
#pragma unroll
    for (int s = 0; s < 2; ++s) { unsigned w[4];
#pragma unroll
        for (int i = 0; i < 4; ++i) { const int j0 = 2 * i, j1 = 2 * i + 1; const int k0 = 16 * s + 8 * (j0 >> 2) + 4 * hh + (j0 & 3), k1 = 16 * s + 8 * (j1 >> 2) + 4 * hh + (j1 & 3);
            w[i] = (k0 >= n ? 0x3F80u : 0u) | (k1 >= n ? 0x3F800000u : 0u); }
        ut[s] = mk8(w[0], w[1], w[2], w[3]); }
    f32x16 O0, O1;
#pragma unroll
    for (int r = 0; r < 16; ++r) { O0[r] = 0.f; O1[r] = 0.f; }
    float carry = 0.f;
    const int srow = lane >> 1, sp0 = (lane & 1) * 4;
    const bf16* kg = base + (size_t)srow * DINP + C_SK + h * 64 + sp0 * 8;
    const bf16* vg = base + (size_t)srow * DINP + C_SV + h * 64 + sp0 * 8;
    LAS unsigned char* sdst = wl + srow * SB_STRIDE + sp0 * 16;
    v4u kr[4], vr[4];
#pragma unroll
    for (int i = 0; i < 4; ++i) { kr[i] = *(const v4u*)(kg + (size_t)tq0 * DINP + 8 * i); vr[i] = *(const v4u*)(vg + (size_t)tq0 * DINP + 8 * i); }
#pragma unroll
    for (int i = 0; i < 4; ++i) { *(LAS v4u*)(sdst + 16 * i) = kr[i]; *(LAS v4u*)(sdst + 32 * SB_STRIDE + 16 * i) = vr[i]; }
    for (int k0 = tq0;; k0 -= 32) {
        const bool more = k0 > 0; const int kn = more ? k0 - 32 : 0;
#pragma unroll
        for (int i = 0; i < 4; ++i) { kr[i] = *(const v4u*)(kg + (size_t)kn * DINP + 8 * i); vr[i] = *(const v4u*)(vg + (size_t)kn * DINP + 8 * i); }
        __builtin_amdgcn_sched_barrier(0);
        {
            const LAS unsigned char* Kt = wl; const LAS unsigned char* Vt = wl + 32 * SB_STRIDE;
            const bool diag = (k0 == tq0);
            f32x16 acc;
#pragma unroll
            for (int r = 0; r < 16; ++r) acc[r] = 0.f;
            { const LAS unsigned char* kp = Kt + n * SB_STRIDE + hh * 16;
#pragma unroll
              for (int ks = 0; ks < 4; ++ks) { const bf16x8 kf = *(const LAS bf16x8*)(kp + ks * 32); acc = __builtin_amdgcn_mfma_f32_32x32x16_bf16(kf, qf[ks], acc, 0, 0, 0); } }
            float z[16], sp[16], lo[16];
#pragma unroll
            for (int r = 0; r < 16; ++r) { z[r] = acc[r] * SC; const bool valid = !diag || (crow(r, hh) < n);
                const float e = __builtin_amdgcn_exp2f(z[r]); float s = __builtin_amdgcn_logf(1.0f + e); s = z[r] > 24.f ? z[r] : s; sp[r] = valid ? s : 0.f; }
            unsigned hw[8];
#pragma unroll
            for (int i = 0; i < 8; ++i) { hw[i] = cvtpk(sp[2 * i], sp[2 * i + 1]); lo[2 * i] = sp[2 * i] - __uint_as_float(hw[i] << 16); lo[2 * i + 1] = sp[2 * i + 1] - __uint_as_float(hw[i] & 0xffff0000u); }
            f32x16 cum;
#pragma unroll
            for (int r = 0; r < 16; ++r) cum[r] = carry;
            cum = __builtin_amdgcn_mfma_f32_32x32x16_bf16(ut[0], mk8(hw[0], hw[1], hw[2], hw[3]), cum, 0, 0, 0);
            cum = __builtin_amdgcn_mfma_f32_32x32x16_bf16(ut[1], mk8(hw[4], hw[5], hw[6], hw[7]), cum, 0, 0, 0);
            cum = __builtin_amdgcn_mfma_f32_32x32x16_bf16(ut[0], pack8(lo), cum, 0, 0, 0);
            cum = __builtin_amdgcn_mfma_f32_32x32x16_bf16(ut[1], pack8(lo + 8), cum, 0, 0, 0);
            float av[16];
#pragma unroll
            for (int r = 0; r < 16; ++r) { const bool valid = !diag || (crow(r, hh) < n); av[r] = valid ? __builtin_amdgcn_exp2f(z[r] - cum[r]) : 0.f; }
            carry = half_bcast_lo(cum[0]);
            const bf16x8 pa0 = pack8(av), pa1 = pack8(av + 8);
            const int vcol = 16 * ((lane >> 4) & 1);
            O0 = __builtin_amdgcn_mfma_f32_32x32x16_bf16(tr_frag(Vt, SB_STRIDE, 4 * hh, vcol, lane), pa0, O0, 0, 0, 0);
            O0 = __builtin_amdgcn_mfma_f32_32x32x16_bf16(tr_frag(Vt, SB_STRIDE, 16 + 4 * hh, vcol, lane), pa1, O0, 0, 0, 0);
            O1 = __builtin_amdgcn_mfma_f32_32x32x16_bf16(tr_frag(Vt, SB_STRIDE, 4 * hh, 32 + vcol, lane), pa0, O1, 0, 0, 0);
            O1 = __builtin_amdgcn_mfma_f32_32x32x16_bf16(tr_frag(Vt, SB_STRIDE, 16 + 4 * hh, 32 + vcol, lane), pa1, O1, 0, 0, 0);
        }
        const bool live = __builtin_amdgcn_ballot_w64(!(carry > SB_EXIT)) != 0ull;
        if (!more || !live) break;
#pragma unroll
        for (int i = 0; i < 4; ++i) { *(LAS v4u*)(sdst + 16 * i) = kr[i]; *(LAS v4u*)(sdst + 32 * SB_STRIDE + 16 * i) = vr[i]; }
    }
    float ss = 0.f;
#pragma unroll
    for (int r = 0; r < 16; ++r) ss += O0[r] * O0[r] + O1[r] * O1[r];
    ss = half_sum(ss);
    const float rn = rsqrtf(ss * (1.0f / 64.0f) + EPS);
    const float* nw = sbnw + layer * 64;
    bf16* op = OMIX + (size_t)(b * SEQ + tq0 + n) * D + 768 + h * 64;
#pragma unroll
    for (int md = 0; md < 2; ++md)
#pragma unroll
        for (int r4 = 0; r4 < 4; ++r4) { const int d0 = 32 * md + 8 * r4 + 4 * hh; const f32x4 g = *(const f32x4*)(nw + d0);
            const float y0 = (md ? O1[4 * r4] : O0[4 * r4]) * rn * g[0], y1 = (md ? O1[4 * r4 + 1] : O0[4 * r4 + 1]) * rn * g[1], y2 = (md ? O1[4 * r4 + 2] : O0[4 * r4 + 2]) * rn * g[2], y3 = (md ? O1[4 * r4 + 3] : O0[4 * r4 + 3]) * rn * g[3];
            u32x2 w; w.x = cvtpk(y0, y1); w.y = cvtpk(y2, y3); *(u32x2*)(op + d0) = w; }
}
constexpr int DSW_STRIDE = 144, DSW_ROWS = 384, DSW_VOFF = DSW_ROWS * DSW_STRIDE;
constexpr size_t DSWO_CFG = (size_t)T * 384, DSWL_OFF = 72 * MiB, DSWL_CFG = (size_t)T * 6;
struct DswU { int b, h, r, rho, nb; };
__device__ __forceinline__ DswU dsw_decode(int u) { DswU d; const int bh = u / 48, rem = u % 48, cfg = rem >> 4, sub = rem & 15; d.b = bh / 6; d.h = bh % 6; d.r = cfg == 0 ? 1 : (cfg == 1 ? 4 : 16);
    const int nsb = 16 / d.r; d.rho = sub / nsb; d.nb = sub % nsb; return d; }
__device__ __forceinline__ void dsw_fetch(const DswU& d, const bf16* PROJ, v4u (&kr)[6], v4u (&vr)[6], bf16x8 (&qn)[4], int tid) {
    { const int lane_ = tid & 63, wave_ = tid >> 6; const int tokq_ = (256 * d.nb + 32 * wave_ + (lane_ & 31)) * d.r + d.rho;
      const bf16* qp = PROJ + (size_t)(d.b * SEQ + tokq_) * DINP + C_DQ + d.h * 64 + 8 * (lane_ >> 5);
#pragma unroll
      for (int ks = 0; ks < 4; ++ks) qn[ks] = *(const bf16x8*)(qp + 16 * ks); }
    const bf16* base = PROJ + (size_t)(d.b * SEQ) * DINP + d.h * 64 + (tid & 7) * 8;
#pragma unroll
    for (int i = 0; i < 6; ++i) { const int ks = 256 * d.nb - 128 + (tid >> 3) + 64 * i; const int kc = ks < 0 ? 0 : ks;
        const bf16* rp = base + (size_t)(kc * d.r + d.rho) * DINP; kr[i] = *(const v4u*)(rp + C_DK); vr[i] = *(const v4u*)(rp + C_DV); }
}
__device__ __forceinline__ void dsw_stage(const v4u (&kr)[6], const v4u (&vr)[6], int nb, LAS unsigned char* lds, int tid) {
#pragma unroll
    for (int i = 0; i < 6; ++i) { LAS unsigned char* p = lds + ((tid >> 3) + 64 * i) * DSW_STRIDE + (tid & 7) * 16; const bool ok = 256 * nb - 128 + (tid >> 3) + 64 * i >= 0; const v4u z = {0u, 0u, 0u, 0u};
        *(LAS v4u*)p = ok ? kr[i] : z; *(LAS v4u*)(p + DSW_VOFF) = ok ? vr[i] : z; }
}
__device__ __forceinline__ void dsw_compute(const DswU& d, int cfg, const bf16x8 (&qf)[4], bf16* DSWO, float* DSWL, const LAS unsigned char* lds, int wave, int lane) {
    int n_ = lane & 31, hh_ = lane >> 5; asm volatile("" : "+v"(n_), "+v"(hh_));
    const int n = n_, hh = hh_;
    constexpr float SC = 0.125f * 1.4426950408889634f;
    const float slope2 = exp2f(-8.0f * (float)(d.h + 1) / 6.0f) * (float)d.r * 1.4426950408889634f;
    const int tokq = (256 * d.nb + 32 * wave + n) * d.r + d.rho;
    float sc[5][16]; float mx = -3.0e38f;
    const bool first = (d.nb == 0);
    const int nq = n - 4 * hh; const float nbase = -slope2 * (float)(nq + 128);
#pragma unroll
    for (int j = 0; j < 5; ++j) {
        if (first && wave + j < 4) {
#pragma unroll
            for (int r = 0; r < 16; ++r) sc[j][r] = -3.0e38f;
        } else {
            f32x16 acc;
#pragma unroll
            for (int r = 0; r < 16; ++r) acc[r] = 0.f;
            const LAS unsigned char* kp = lds + (32 * (wave + j) + n) * DSW_STRIDE + hh * 16;
#pragma unroll
            for (int ks = 0; ks < 4; ++ks) { const bf16x8 kf = *(const LAS bf16x8*)(kp + ks * 32); acc = __builtin_amdgcn_mfma_f32_32x32x16_bf16(kf, qf[ks], acc, 0, 0, 0); }
#pragma unroll
            for (int r = 0; r < 16; ++r) { const int cr = (r & 3) + 8 * (r >> 2); const float bias = slope2 * (float)(32 * j + cr) + nbase;
                float v = acc[r] * SC + bias;
                if (j == 0) v = (cr >= nq) ? v : -3.0e38f;
                if (j == 4) v = (cr <= nq) ? v : -3.0e38f;
                sc[j][r] = v; mx = fmaxf(mx, v); }
        }
    }
    mx = half_max(mx);
    float l = 0.f;
#pragma unroll
    for (int j = 0; j < 5; ++j)
#pragma unroll
        for (int r = 0; r < 16; ++r) { const float p = __builtin_amdgcn_exp2f(sc[j][r] - mx); sc[j][r] = p; l += p; }
    l = half_sum(l);
    f32x16 O0, O1;
#pragma unroll
    for (int r = 0; r < 16; ++r) { O0[r] = 0.f; O1[r] = 0.f; }
    const int vcol = 16 * ((lane >> 4) & 1);
#pragma unroll
    for (int j = 0; j < 5; ++j) { const LAS unsigned char* Vt = lds + DSW_VOFF + 32 * (wave + j) * DSW_STRIDE;
        const bf16x8 pa0 = pack8(sc[j]), pa1 = pack8(sc[j] + 8);
        O0 = __builtin_amdgcn_mfma_f32_32x32x16_bf16(tr_frag(Vt, DSW_STRIDE, 4 * hh, vcol, lane), pa0, O0, 0, 0, 0);
        O0 = __builtin_amdgcn_mfma_f32_32x32x16_bf16(tr_frag(Vt, DSW_STRIDE, 16 + 4 * hh, vcol, lane), pa1, O0, 0, 0, 0);
        O1 = __builtin_amdgcn_mfma_f32_32x32x16_bf16(tr_frag(Vt, DSW_STRIDE, 4 * hh, 32 + vcol, lane), pa0, O1, 0, 0, 0);
        O1 = __builtin_amdgcn_mfma_f32_32x32x16_bf16(tr_frag(Vt, DSW_STRIDE, 16 + 4 * hh, 32 + vcol, lane), pa1, O1, 0, 0, 0); }
    const float il = 1.0f / l;
    const size_t trow = (size_t)(d.b * SEQ + tokq);
    bf16* op = DSWO + (size_t)cfg * DSWO_CFG + trow * 384 + d.h * 64;
#pragma unroll
    for (int md = 0; md < 2; ++md)
#pragma unroll
        for (int r4 = 0; r4 < 4; ++r4) { const int d0 = 32 * md + 8 * r4 + 4 * hh;
            const float y0 = (md ? O1[4 * r4] : O0[4 * r4]) * il, y1 = (md ? O1[4 * r4 + 1] : O0[4 * r4 + 1]) * il, y2 = (md ? O1[4 * r4 + 2] : O0[4 * r4 + 2]) * il, y3 = (md ? O1[4 * r4 + 3] : O0[4 * r4 + 3]) * il;
            u32x2 w; w.x = cvtpk(y0, y1); w.y = cvtpk(y2, y3); *(u32x2*)(op + d0) = w; }
    if (hh == 0) DSWL[(size_t)cfg * DSWL_CFG + trow * 6 + d.h] = mx + __builtin_amdgcn_logf(l);
}
__device__ __forceinline__ void dsw_phase(const bf16* PROJ, bf16* DSWO, float* DSWL, LAS unsigned char* lds, int vcu, int G, int wave, int lane, int tid) {
    v4u kr[6], vr[6]; bf16x8 qn[4], qc[4];
    int u = vcu;
    if (u >= 2304) return;
    DswU d = dsw_decode(u);
    dsw_fetch(d, PROJ, kr, vr, qn, tid); dsw_stage(kr, vr, d.nb, lds, tid);
    __syncthreads();
    for (;;) {
        const int un = u + G; const bool has_next = un < 2304; DswU dn = d;
#pragma unroll
        for (int ks = 0; ks < 4; ++ks) qc[ks] = qn[ks];
        dn = dsw_decode(has_next ? un : u); dsw_fetch(dn, PROJ, kr, vr, qn, tid);
        __builtin_amdgcn_sched_barrier(0);
        dsw_compute(d, (u % 48) >> 4, qc, DSWO, DSWL, lds, wave, lane);
        __syncthreads();
        if (!has_next) break;
        dsw_stage(kr, vr, dn.nb, lds, tid);
        __syncthreads();
        u = un; d = dn;
    }
}
__device__ __forceinline__ void dsw_combine_phase(const bf16* DSWO, const float* DSWL, const float* nw, bf16* OMIX, int gw, int NGW, int lane) {
    const int seg = lane & 7; const f32x4 g0 = *(const f32x4*)(nw + seg * 8), g1 = *(const f32x4*)(nw + seg * 8 + 4);
    for (int it = gw; it < T * 6 / 8; it += NGW) { const int item = it * 8 + (lane >> 3); const int t = item / 6, h = item % 6;
        const float l0 = DSWL[(size_t)t * 6 + h], l1 = DSWL[DSWL_CFG + (size_t)t * 6 + h], l2 = DSWL[2 * DSWL_CFG + (size_t)t * 6 + h];
        const float m = fmaxf(l0, fmaxf(l1, l2)); float w0 = __builtin_amdgcn_exp2f(l0 - m), w1 = __builtin_amdgcn_exp2f(l1 - m), w2 = __builtin_amdgcn_exp2f(l2 - m); const float iw = 1.0f / (w0 + w1 + w2); w0 *= iw; w1 *= iw; w2 *= iw;
        const bf16* p0 = DSWO + (size_t)t * 384 + h * 64 + seg * 8;
        const v4u a = *(const v4u*)p0, b = *(const v4u*)(p0 + DSWO_CFG), c = *(const v4u*)(p0 + 2 * DSWO_CFG);
        float o[8];
        o[0] = w0 * bflo(a.x) + w1 * bflo(b.x) + w2 * bflo(c.x); o[1] = w0 * bfhi(a.x) + w1 * bfhi(b.x) + w2 * bfhi(c.x);
        o[2] = w0 * bflo(a.y) + w1 * bflo(b.y) + w2 * bflo(c.y); o[3] = w0 * bfhi(a.y) + w1 * bfhi(b.y) + w2 * bfhi(c.y);
        o[4] = w0 * bflo(a.z) + w1 * bflo(b.z) + w2 * bflo(c.z); o[5] = w0 * bfhi(a.z) + w1 * bfhi(b.z) + w2 * bfhi(c.z);
        o[6] = w0 * bflo(a.w) + w1 * bflo(b.w) + w2 * bflo(c.w); o[7] = w0 * bfhi(a.w) + w1 * bfhi(b.w) + w2 * bfhi(c.w);
        float ss = 0.f;
#pragma unroll
        for (int i = 0; i < 8; ++i) ss += o[i] * o[i];
        ss += SWZ_XOR(ss, 1); ss += SWZ_XOR(ss, 2); ss += SWZ_XOR(ss, 4);
        const float rn = rsqrtf(ss * (1.0f / 64.0f) + EPS);
        v4u w; w.x = pk2(o[0] * rn * g0[0], o[1] * rn * g0[1]); w.y = pk2(o[2] * rn * g0[2], o[3] * rn * g0[3]); w.z = pk2(o[4] * rn * g1[0], o[5] * rn * g1[1]); w.w = pk2(o[6] * rn * g1[2], o[7] * rn * g1[3]);
        *(v4u*)(OMIX + (size_t)t * D + 384 + h * 64 + seg * 8) = w; }
}
constexpr size_t GDN_A = 0, GDN_B = 24 * MiB, GDN_C = 72 * MiB, GDN_D = 96 * MiB, GDN_ST = 120 * MiB, GDN_GT = 144 * MiB;
constexpr int GS = 144;
constexpr int GL_Q = 0, GL_K = 9216, GL_V = 18432, GL_L = 27648, GL_W = 27648, GL_QK = 46080, GL_U = 55296, GL_VEC = 64512, GL_BYTES = 65536;
__device__ __forceinline__ bf16x8 frag16_row(const LAS unsigned char* Tt, int x0, int k0, int lane) { return *(const LAS bf16x8*)(Tt + (x0 + (lane & 15)) * GS + (k0 + 8 * (lane >> 4)) * 2); }
__device__ __forceinline__ bf16x8 frag16_tr(const LAS unsigned char* Tt, int k0, int x0, int lane) {
    const LAS unsigned char* p = Tt + (k0 + 8 * (lane >> 4) + ((lane & 15) >> 2)) * GS + (x0 + 4 * (lane & 3)) * 2;
    const v4i16_t a = __builtin_amdgcn_ds_read_tr16_b64_v4i16((LAS v4i16_t*)p);
    const v4i16_t b = __builtin_amdgcn_ds_read_tr16_b64_v4i16((LAS v4i16_t*)(p + 4 * GS));
    return (bf16x8){a[0], a[1], a[2], a[3], b[0], b[1], b[2], b[3]};
}
#define MFMA16(a, b, c) __builtin_amdgcn_mfma_f32_16x16x32_bf16((a), (b), (c), 0, 0, 0)

typedef float f32x2g __attribute__((ext_vector_type(2)));
__device__ __forceinline__ void gdn_solve_col(f32x2g (&xp)[32], const LAS float* Lf) {
#pragma unroll
    for (int b = 0; b < 16; ++b) { const int i0 = 4 * b;
        const LAS float* Lb = Lf + i0 * 72;
        if (b > 0) asm volatile("" : "+v"(Lb) : "v"(xp[2 * b - 1]));
        f32x2g sa[4], sb[4];
#pragma unroll
        for (int r = 0; r < 4; ++r) { sa[r] = (f32x2g){0.f, 0.f}; sb[r] = (f32x2g){0.f, 0.f}; }
#pragma unroll
        for (int j4 = 0; j4 < b; ++j4)
#pragma unroll
            for (int r = 0; r < 4; ++r) { const f32x4 l = *(const LAS f32x4*)(Lb + r * 72 + 4 * j4);
                sa[r] += __builtin_shufflevector(l, l, 0, 1) * xp[2 * j4]; sb[r] += __builtin_shufflevector(l, l, 2, 3) * xp[2 * j4 + 1]; }
        const f32x4 d1 = *(const LAS f32x4*)(Lb + 1 * 72 + i0), d2 = *(const LAS f32x4*)(Lb + 2 * 72 + i0), d3 = *(const LAS f32x4*)(Lb + 3 * 72 + i0);
        float t[4];
#pragma unroll
        for (int r = 0; r < 4; ++r) t[r] = (sa[r][0] + sa[r][1]) + (sb[r][0] + sb[r][1]);
        const float x0 = xp[2 * b][0] - t[0];
        const float x1 = xp[2 * b][1] - (t[1] + d1[0] * x0);
        const float x2 = xp[2 * b + 1][0] - (t[2] + d2[0] * x0 + d2[1] * x1);
        const float x3 = xp[2 * b + 1][1] - (t[3] + d3[0] * x0 + d3[1] * x1 + d3[2] * x2);
        xp[2 * b] = (f32x2g){x0, x1}; xp[2 * b + 1] = (f32x2g){x2, x3}; }
}

__device__ __forceinline__ void gdn_g1_phase(int layer, const float* convw, const float* alog, const float* dtbias, const bf16* PROJ, unsigned char* gws, LAS unsigned char* lds, int vcu, int G, int wave, int lane_in, int tid_in) {
    const int grp = wave >> 2, gw4 = wave & 3;
    LAS unsigned char* gl = lds + grp * GL_BYTES;
    LAS float* vec = (LAS float*)(gl + GL_VEC);
    const float* cw = convw + (size_t)layer * 4 * 1152;
#define G1_BAR() do { asm volatile("s_waitcnt lgkmcnt(0)" ::: "memory"); __builtin_amdgcn_s_barrier(); asm volatile("" ::: "memory"); } while (0)
#define G1_LOADS(PP, AL, BL) do { int gt_ = tid_in & 255; asm volatile("" : "+v"(gt_)); const int c_ = 2 * (PP) + grp, bh_ = c_ >> 6, n_ = c_ & 63, b_ = bh_ / 6, h_ = bh_ % 6; const bf16* base_ = PROJ + (size_t)(b_ * SEQ) * DINP; \
        _Pragma("unroll") for (int i = 0; i < 3; ++i) { const int q = gt_ + 256 * i, w = q / 192, rem = q % 192; tap[i] = cw[w * 1152 + (rem >> 6) * 384 + h_ * 64 + (rem & 63)]; } \
        { const bf16* gbp = base_ + (size_t)(n_ * 64 + (gt_ & 63)) * DINP; AL = gbp[C_GA + h_]; BL = gbp[C_GB + h_]; } \
        _Pragma("unroll") for (int it = 0; it < 6; ++it) { const int idx = it * 256 + gt_, seg = idx & 7, rp = idx >> 3, part = it >> 1, row = rp & 63, pos = n_ * 64 + row; const int ch = part * 384 + h_ * 64 + seg * 8; \
            _Pragma("unroll") for (int w = 0; w < 4; ++w) { const int p = pos - 3 + w; xr[it][w] = *(const v4u*)(base_ + (size_t)(p < 0 ? 0 : p) * DINP + ch); } } } while (0)
    if (vcu >= 1536) return;
    float tap[3]; v4u xr[6][4]; bf16 al_b, bl_b, al_n, bl_n;
    G1_LOADS(vcu, al_b, bl_b);
    for (int pp = vcu;;) {
        int lane_ = lane_in, gtid_ = tid_in & 255; asm volatile("" : "+v"(lane_), "+v"(gtid_));
        const int lane = lane_, gtid = gtid_;
        const int c = 2 * pp + grp, bh = c >> 6, n = c & 63, b = bh / 6, h = bh % 6;
        LAS float* cwl = (LAS float*)(gl + GL_QK);
#pragma unroll
        for (int i = 0; i < 3; ++i) cwl[gtid + 256 * i] = tap[i];
        G1_BAR();
#pragma unroll
        for (int it = 0; it < 6; ++it) { const int idx = it * 256 + gtid, seg = idx & 7, rp = idx >> 3, part = it >> 1, row = rp & 63, pos = n * 64 + row;
            float y[8];
#pragma unroll
            for (int e = 0; e < 8; ++e) y[e] = 0.f;
#pragma unroll
            for (int w = 0; w < 4; ++w) { v4u x = xr[it][w]; if (pos - 3 + w < 0) x = (v4u){0u, 0u, 0u, 0u};
                const LAS f32x4* cp = (const LAS f32x4*)(cwl + w * 192 + part * 64 + seg * 8); const f32x4 c0 = cp[0], c1 = cp[1];
                y[0] += c0[0] * bflo(x.x); y[1] += c0[1] * bfhi(x.x); y[2] += c0[2] * bflo(x.y); y[3] += c0[3] * bfhi(x.y); y[4] += c1[0] * bflo(x.z); y[5] += c1[1] * bfhi(x.z); y[6] += c1[2] * bflo(x.w); y[7] += c1[3] * bfhi(x.w); }
            float ss = 0.f;
#pragma unroll
            for (int e = 0; e < 8; ++e) { y[e] = silu_f(y[e]); ss += y[e] * y[e]; }
            if (part < 2) { ss += SWZ_XOR(ss, 1); ss += SWZ_XOR(ss, 2); ss += SWZ_XOR(ss, 4); const float rn = rsqrtf(ss + EPS);
#pragma unroll
                for (int e = 0; e < 8; ++e) y[e] *= rn; }
            v4u o; o.x = cvtpk(y[0], y[1]); o.y = cvtpk(y[2], y[3]); o.z = cvtpk(y[4], y[5]); o.w = cvtpk(y[6], y[7]);
            *(LAS v4u*)(gl + (part == 0 ? GL_Q : (part == 1 ? GL_K : GL_V)) + row * GS + seg * 16) = o; }
        if (gw4 == 0) { float gv = -expf(alog[layer * 6 + h]) * softplus_f(bf2f(al_b) + dtbias[layer * 6 + h]); const float bv = sigm_f(bf2f(bl_b));
#pragma unroll
            for (int off = 1; off < 64; off <<= 1) { const float t_ = __int_as_float(__builtin_amdgcn_ds_bpermute(((lane - off) & 63) << 2, __float_as_int(gv))); if (lane >= off) gv += t_; }
            const float Gt = __int_as_float(__builtin_amdgcn_readlane(__float_as_int(gv), 63));
            vec[lane] = gv; vec[64 + lane] = bv; vec[128 + lane] = __expf(gv); vec[192 + lane] = __expf(Gt - gv); }
        G1_BAR();
        f32x2g xp[32];
        const bool solver = (gw4 >> 1) == grp;
        const int scol = (gw4 & 1) * 64 + lane;
        if (solver) { const int col = scol;
            const LAS bf16* src = (const LAS bf16*)(gl + (col < 64 ? GL_V : GL_K)) + (col & 63);
#pragma unroll
            for (int i = 0; i < 64; ++i) { const float bi = vec[64 + i]; xp[i >> 1][i & 1] = bf2f(src[i * 72]) * bi * (col < 64 ? 1.0f : vec[128 + i]); } }
        { const int q4 = lane >> 4, cl = lane & 15;
          bf16x8 ka[2], qa[2];
#pragma unroll
          for (int ks = 0; ks < 2; ++ks) { ka[ks] = frag16_row(gl + GL_K, 16 * gw4, 32 * ks, lane); qa[ks] = frag16_row(gl + GL_Q, 16 * gw4, 32 * ks, lane); }
          float Gr[4], br[4];
#pragma unroll
          for (int r = 0; r < 4; ++r) { Gr[r] = vec[16 * gw4 + 4 * q4 + r]; br[r] = vec[64 + 16 * gw4 + 4 * q4 + r]; }
#pragma unroll
          for (int nj = 0; nj < 4; ++nj) {
              LAS float* Lp = (LAS float*)(gl + GL_L); LAS bf16* QKp = (LAS bf16*)(gl + GL_QK);
              if (nj <= gw4) {
                  f32x4 kk = {0.f, 0.f, 0.f, 0.f}, qk = {0.f, 0.f, 0.f, 0.f};
#pragma unroll
                  for (int ks = 0; ks < 2; ++ks) { const bf16x8 kb = frag16_row(gl + GL_K, 16 * nj, 32 * ks, lane); kk = MFMA16(ka[ks], kb, kk); qk = MFMA16(qa[ks], kb, qk); }
                  const int j = 16 * nj + cl; const float Gj = vec[j];
#pragma unroll
                  for (int r = 0; r < 4; ++r) { const int i = 16 * gw4 + 4 * q4 + r; const float dec = __expf(Gr[r] - Gj);
                      Lp[i * 72 + j] = (j < i) ? br[r] * kk[r] * dec : 0.f;
                      QKp[i * 72 + j] = (bf16)f2bf((j <= i) ? qk[r] * 0.125f * dec : 0.f); }
              } else {
#pragma unroll
                  for (int r = 0; r < 4; ++r) { const int i = 16 * gw4 + 4 * q4 + r; QKp[i * 72 + 16 * nj + cl] = (bf16)0; }
              } } }
        G1_BAR();
        if (solver) gdn_solve_col(xp, (const LAS float*)(gl + GL_L));
        else {
#pragma unroll
            for (int it = 0; it < 4; ++it) { const int idx = it * 128 + scol, row = idx >> 3, seg = idx & 7; LAS v4u* p = (LAS v4u*)(gl + GL_K + row * GS + seg * 16); const v4u k = *p; const float s = vec[192 + row];
                v4u o; o.x = cvtpk(bflo(k.x) * s, bfhi(k.x) * s); o.y = cvtpk(bflo(k.y) * s, bfhi(k.y) * s); o.z = cvtpk(bflo(k.z) * s, bfhi(k.z) * s); o.w = cvtpk(bflo(k.w) * s, bfhi(k.w) * s); *p = o; } }
        G1_BAR();
        if (solver) { const int col = scol; LAS unsigned char* dst = gl + (col < 64 ? GL_U : GL_W) + (col & 63) * GS;
#pragma unroll
            for (int jj = 0; jj < 8; ++jj) { v4u o; o.x = cvtpk(xp[4 * jj][0], xp[4 * jj][1]); o.y = cvtpk(xp[4 * jj + 1][0], xp[4 * jj + 1][1]); o.z = cvtpk(xp[4 * jj + 2][0], xp[4 * jj + 2][1]); o.w = cvtpk(xp[4 * jj + 3][0], xp[4 * jj + 3][1]); *(LAS v4u*)(dst + 16 * jj) = o; } }
        G1_BAR();
        const int ppn = pp + G; const bool has_next = ppn < 1536;
        G1_LOADS(has_next ? ppn : pp, al_n, bl_n);
        __builtin_amdgcn_sched_barrier(0);
        { const int q4 = lane >> 4, cl = lane & 15, m0 = 16 * gw4 + 4 * q4, pm = 16 * q4 + 4 * gw4;
          const size_t cs = (size_t)(n * 48 + bh) * 4096;
          bf16* Ag = (bf16*)(gws + GDN_A) + cs; bf16* Bg = (bf16*)(gws + GDN_B) + cs; bf16* Cg = (bf16*)(gws + GDN_C) + cs; bf16* Dg = (bf16*)(gws + GDN_D) + cs;
          bf16x8 wa[2], ua[2], kda[2];
#pragma unroll
          for (int ks = 0; ks < 2; ++ks) { wa[ks] = frag16_row(gl + GL_W, 16 * gw4, 32 * ks, lane); ua[ks] = frag16_row(gl + GL_U, 16 * gw4, 32 * ks, lane); kda[ks] = frag16_tr(gl + GL_K, 32 * ks, 16 * gw4, lane); }
#pragma unroll
          for (int nt = 0; nt < 4; ++nt) {
              f32x4 am = {0.f, 0.f, 0.f, 0.f}, bm = {0.f, 0.f, 0.f, 0.f}, cm = {0.f, 0.f, 0.f, 0.f}, dm = {0.f, 0.f, 0.f, 0.f};
#pragma unroll
              for (int ks = 0; ks < 2; ++ks) { const bf16x8 kdb = frag16_tr(gl + GL_K, 32 * ks, 16 * nt, lane), ub = frag16_row(gl + GL_U, 16 * nt, 32 * ks, lane), qkb = frag16_row(gl + GL_QK, 16 * nt, 32 * ks, lane);
                  am = MFMA16(wa[ks], kdb, am);
                  bm = MFMA16(kda[ks], ub, bm);
                  cm = MFMA16(wa[ks], qkb, cm);
                  dm = MFMA16(ua[ks], qkb, dm); }
              const int nn = 16 * nt + cl;
              { u32x2 o; o.x = cvtpk(-am[0], -am[1]); o.y = cvtpk(-am[2], -am[3]); *(u32x2*)(Ag + nn * 64 + pm) = o; }
              { u32x2 o; o.x = cvtpk(bm[0], bm[1]); o.y = cvtpk(bm[2], bm[3]); *(u32x2*)(Bg + nn * 64 + pm) = o; }
              { const u32x2 qv = *(const LAS u32x2*)(gl + GL_Q + nn * GS + m0 * 2); const float sq = vec[128 + nn] * 0.125f;
                u32x2 o; o.x = cvtpk(bflo(qv.x) * sq - cm[0], bfhi(qv.x) * sq - cm[1]); o.y = cvtpk(bflo(qv.y) * sq - cm[2], bfhi(qv.y) * sq - cm[3]); *(u32x2*)(Cg + nn * 64 + pm) = o; }
              { u32x2 o; o.x = cvtpk(dm[0], dm[1]); o.y = cvtpk(dm[2], dm[3]); *(u32x2*)(Dg + nn * 64 + pm) = o; }
          }
          if (gtid == 0) ((float*)(gws + GDN_GT))[c] = vec[128 + 63]; }
        G1_BAR();
        if (!has_next) break;
        pp = ppn; al_b = al_n; bl_b = bl_n;
    }
#undef G1_BAR
#undef G1_LOADS
}

struct ScanOps { bf16x8 af[4][2]; v4u bq[2]; };
#define SCAN_LOAD(R, nn) do { { const int nc_ = (nn) < 64 ? (nn) : 63;     \
    const bf16* An_ = Ag + (size_t)nc_ * (48 * 4096); const bf16* Bn_ = Bg + (size_t)nc_ * (48 * 4096) + (16 * es + cl) * 64 + 16 * q4; \
    _Pragma("unroll") for (int md = 0; md < 4; ++md) { _Pragma("unroll") for (int ks = 0; ks < 2; ++ks) R.af[md][ks] = *(const bf16x8*)(An_ + (16 * md + cl) * 64 + 32 * ks + 8 * q4); } \
    R.bq[0] = *(const v4u*)Bn_; R.bq[1] = *(const v4u*)(Bn_ + 8); } } while (0)
#define SCAN_BQ(R, md) (f32x4){bflo((md) & 1 ? R.bq[(md) >> 1].z : R.bq[(md) >> 1].x), bfhi((md) & 1 ? R.bq[(md) >> 1].z : R.bq[(md) >> 1].x), bflo((md) & 1 ? R.bq[(md) >> 1].w : R.bq[(md) >> 1].y), bfhi((md) & 1 ? R.bq[(md) >> 1].w : R.bq[(md) >> 1].y)}
#define SCAN_STEP(R, nn) do { \
    v4u o0_, o1_; o0_.x = cvtpk(S[0][0], S[0][1]); o0_.y = cvtpk(S[0][2], S[0][3]); o0_.z = cvtpk(S[1][0], S[1][1]); o0_.w = cvtpk(S[1][2], S[1][3]); \
    o1_.x = cvtpk(S[2][0], S[2][1]); o1_.y = cvtpk(S[2][2], S[2][3]); o1_.z = cvtpk(S[3][0], S[3][1]); o1_.w = cvtpk(S[3][2], S[3][3]); \
    { bf16* sp_ = STg + (size_t)(nn) * (48 * 4096) + (16 * es + cl) * 64 + 16 * q4; *(v4u*)sp_ = o0_; *(v4u*)(sp_ + 8) = o1_; } \
    *(LAS v4u*)(wl + cl * GS + q4 * 32) = o0_; *(LAS v4u*)(wl + cl * GS + q4 * 32 + 16) = o1_; \
    const bf16x8 sb0 = *(const LAS bf16x8*)(wl + cl * GS + (8 * q4) * 2), sb1 = *(const LAS bf16x8*)(wl + cl * GS + (32 + 8 * q4) * 2); \
    const float gt_ = __int_as_float(__builtin_amdgcn_readlane(__float_as_int(gtv), (nn))); \
    _Pragma("unroll") for (int md = 0; md < 4; ++md) { f32x4 a_ = S[md] * gt_ + SCAN_BQ(R, md); \
        a_ = MFMA16(R.af[md][0], sb0, a_); S[md] = MFMA16(R.af[md][1], sb1, a_); } } while (0)
__device__ __forceinline__ void gdn_scan_unit(int su, unsigned char* gws, LAS unsigned char* wl  , int lane) {
    const int bh = su >> 2, es = su & 3, q4 = lane >> 4, cl = lane & 15;
    const bf16* Ag = (const bf16*)(gws + GDN_A) + (size_t)bh * 4096; const bf16* Bg = (const bf16*)(gws + GDN_B) + (size_t)bh * 4096;
    bf16* STg = (bf16*)(gws + GDN_ST) + (size_t)bh * 4096;
    const float gtv = ((const float*)(gws + GDN_GT))[bh * 64 + lane];
    f32x4 S[4];
#pragma unroll
    for (int md = 0; md < 4; ++md) S[md] = (f32x4){0.f, 0.f, 0.f, 0.f};
    ScanOps r0, r1, r2, r3;
    SCAN_LOAD(r0, 0); SCAN_LOAD(r1, 1); SCAN_LOAD(r2, 2); SCAN_LOAD(r3, 3);
    for (int n = 0; n < 64; n += 4) {
        SCAN_STEP(r0, n); __builtin_amdgcn_sched_barrier(0); SCAN_LOAD(r0, n + 4); __builtin_amdgcn_sched_barrier(0);
        SCAN_STEP(r1, n + 1); __builtin_amdgcn_sched_barrier(0); SCAN_LOAD(r1, n + 5); __builtin_amdgcn_sched_barrier(0);
        SCAN_STEP(r2, n + 2); __builtin_amdgcn_sched_barrier(0); SCAN_LOAD(r2, n + 6); __builtin_amdgcn_sched_barrier(0);
        SCAN_STEP(r3, n + 3); __builtin_amdgcn_sched_barrier(0); SCAN_LOAD(r3, n + 7); __builtin_amdgcn_sched_barrier(0);
    }
}

struct G3Ops { bf16x8 cb[2]; bf16x8 sa[4][2]; u32x2 dv[4]; u32x2 zv[4]; };
#define G3_LOAD(R, wu_) do { const int w_ = (wu_) < 3072 * 4 ? (wu_) : 3072 * 4 - 1; const int c_ = w_ >> 2, ni_ = w_ & 3, bh_ = c_ >> 6, n_ = c_ & 63, b_ = bh_ / 6, h_ = bh_ % 6; \
    const size_t cs_ = (size_t)(n_ * 48 + bh_) * 4096; const bf16* STg_ = (const bf16*)(gws + GDN_ST) + cs_; const bf16* Cg_ = (const bf16*)(gws + GDN_C) + cs_; const bf16* Dg_ = (const bf16*)(gws + GDN_D) + cs_; \
    const bf16* zp_ = PROJ + (size_t)(b_ * SEQ + n_ * 64 + 16 * ni_ + cl) * DINP + C_GZ + h_ * 64; \
    _Pragma("unroll") for (int ks = 0; ks < 2; ++ks) R.cb[ks] = *(const bf16x8*)(Cg_ + (16 * ni_ + cl) * 64 + 32 * ks + 8 * q4); \
    _Pragma("unroll") for (int me = 0; me < 4; ++me) { R.dv[me] = *(const u32x2*)(Dg_ + (16 * ni_ + cl) * 64 + 16 * q4 + 4 * me); R.zv[me] = *(const u32x2*)(zp_ + 16 * me + 4 * q4); \
        _Pragma("unroll") for (int ks = 0; ks < 2; ++ks) R.sa[me][ks] = *(const bf16x8*)(STg_ + (16 * me + cl) * 64 + 32 * ks + 8 * q4); } } while (0)
__device__ __forceinline__ void gdn_g3_unit(const G3Ops& R, int wu, const float* nw, bf16* OMIX, int q4, int cl) {
    const int c = wu >> 2, ni = wu & 3, bh = c >> 6, n = c & 63, b = bh / 6, h = bh % 6;
    f32x4 o[4]; float ss = 0.f;
#pragma unroll
    for (int me = 0; me < 4; ++me) { o[me] = (f32x4){bflo(R.dv[me].x), bfhi(R.dv[me].x), bflo(R.dv[me].y), bfhi(R.dv[me].y)};
#pragma unroll
        for (int ks = 0; ks < 2; ++ks) o[me] = MFMA16(R.sa[me][ks], R.cb[ks], o[me]);
        ss += (o[me][0] * o[me][0] + o[me][1] * o[me][1]) + (o[me][2] * o[me][2] + o[me][3] * o[me][3]); }
    ss += SWZ_XOR(ss, 16); ss = half_sum(ss);
    const float rn = rsqrtf(ss * (1.0f / 64.0f) + EPS);
    bf16* op = OMIX + (size_t)(b * SEQ + n * 64 + 16 * ni + cl) * D + h * 64;
#pragma unroll
    for (int me = 0; me < 4; ++me) { const int e0 = 16 * me + 4 * q4; const u32x2 zv = R.zv[me]; const f32x4 g = *(const f32x4*)(nw + e0);
        u32x2 w; w.x = cvtpk(o[me][0] * rn * g[0] * silu_f(bflo(zv.x)), o[me][1] * rn * g[1] * silu_f(bfhi(zv.x))); w.y = cvtpk(o[me][2] * rn * g[2] * silu_f(bflo(zv.y)), o[me][3] * rn * g[3] * silu_f(bfhi(zv.y)));
        *(u32x2*)(op + e0) = w; }
}
__device__ __forceinline__ void gdn_g3_phase(int layer, const float* gnw, const bf16* PROJ, unsigned char* gws, bf16* OMIX, int gw, int NGW, int lane) {
    const int q4 = lane >> 4, cl = lane & 15; const float* nw = gnw + layer * 64;
    G3Ops r0, r1;
    G3_LOAD(r0, gw);
    for (int wu = gw; wu < 3072 * 4; wu += 2 * NGW) {
        G3_LOAD(r1, wu + NGW); __builtin_amdgcn_sched_barrier(0);
        gdn_g3_unit(r0, wu, nw, OMIX, q4, cl); __builtin_amdgcn_sched_barrier(0);
        G3_LOAD(r0, wu + 2 * NGW); __builtin_amdgcn_sched_barrier(0);
        if (wu + NGW < 3072 * 4) gdn_g3_unit(r1, wu + NGW, nw, OMIX, q4, cl);
        __builtin_amdgcn_sched_barrier(0);
    }
}
#define LAUNDER() do { ap = (const CAS Args*)__builtin_amdgcn_kernarg_segment_ptr(); asm volatile("" : "+s"(ap)); } while (0)
#define A_IN(i) ((const float*)ap->in[i])
#define WSP ((unsigned char*)ap->ws)
#define HOUT ((float*)ap->out)
#define LDSP ((LAS unsigned char*)lds_raw)
#define HD0 ((bf16*)ap->out)
#define HD1 ((bf16*)ap->out + (size_t)T * D)
__device__ __forceinline__ int GX() { int g = gridDim.x; asm volatile("" : "+s"(g)); return g; }
__device__ __forceinline__ int BX() { int b = blockIdx.x; asm volatile("" : "+s"(b)); return b; }
#define GRID_BAR() do { LAUNDER(); XcdBarrier b_; b_.bar = (unsigned*)(WSP + WS_CTL) + CW_BAR; b_.x = xb_xcc_id(); b_.st = (volatile LAS unsigned*)(LDSP + MISC_OFF) + 8; xcd_barrier(b_); } while (0)
#define IDS() int tid_ = wave_s * 64 + mk_lane(), bx_ = blockIdx.x, G_ = gridDim.x; asm volatile("" : "+v"(tid_), "+s"(bx_), "+s"(G_)); const int tid = tid_, lane = tid & 63, wave = __builtin_amdgcn_readfirstlane(tid >> 6); const int G = G_, bx = bx_; \
              const int vcu = (G % 8 == 0) ? (bx % 8) * (G / 8) + bx / 8 : bx; const int gw = vcu * NWAVES + wave, NGW = G * NWAVES; (void)gw; (void)NGW; (void)lane; (void)tid; (void)vcu
constexpr size_t ROWTOK_OFF = 131072 + 262144 + 262144;
static_assert(ROWTOK_OFF + (size_t)MROWS * 4 <= MiB, "ROUTE region");
template <int layer>
__device__ __forceinline__ void layer_body(const int wave_s) {
    extern __shared__ __attribute__((aligned(16))) unsigned char lds_raw[];
    const CAS Args* ap;
        { LAUNDER(); pg8::Gemm g{(const bf16*)HD0, (const bf16*)(WSP + WS_WIN) + (size_t)layer * DINP * D, T, DINP, D, D};     pg8::StaticOrder S; S.init(T, DINP, GX(), BX());
          pg8::build_row_scales(S, (const float*)(WSP + WS_STATA), (LAS float*)(LDSP + RTAB_OFF), wave_s * 64 + mk_lane());
          pg8::EpiStore<true> E{(bf16*)(WSP + WS_PROJ), DINP, 1 << 20, (const LAS float*)(LDSP + RTAB_OFF), 0};
          pg8::gemm_phase<pg8::EpiStore<true>, pg8::StaticOrder, true, true>(LDSP + RING_OFF, g, S, E, wave_s); }
        GRID_BAR();
        { IDS(); LAUNDER(); const bf16* PROJ = (const bf16*)(WSP + WS_PROJ); bf16* OMIX = (bf16*)(WSP + WS_OMIX);
          gdn_g1_phase(layer, A_IN(4), A_IN(5), A_IN(6), PROJ, WSP + WS_GDN, LDSP + RING_OFF, vcu, G, wave, lane, tid);
          __syncthreads(); }
        { IDS(); LAUNDER(); const bf16* PROJ = (const bf16*)(WSP + WS_PROJ); bf16* OMIX = (bf16*)(WSP + WS_OMIX);
          for (int u = gw; u < 4096; u += NGW) sb_wave_unit(u, layer, A_IN(9), PROJ, OMIX, LDSP + RING_OFF + wave * SB_WBYTES, lane);
          }
        GRID_BAR();
        { IDS(); LAUNDER(); const bf16* PROJ = (const bf16*)(WSP + WS_PROJ);
          if (wave == 0 && vcu < 192) gdn_scan_unit(vcu, WSP + WS_GDN, LDSP + RING_OFF + 110592, lane);
          dsw_phase(PROJ, (bf16*)(WSP + WS_DSW), (float*)(WSP + WS_DSW + DSWL_OFF), LDSP + RING_OFF, vcu, G, wave, lane, tid);
          }
        GRID_BAR();
        { IDS(); LAUNDER(); gdn_g3_phase(layer, A_IN(7), (const bf16*)(WSP + WS_PROJ), WSP + WS_GDN, (bf16*)(WSP + WS_OMIX), gw, NGW, lane); }
        { IDS(); LAUNDER(); dsw_combine_phase((const bf16*)(WSP + WS_DSW), (const float*)(WSP + WS_DSW + DSWL_OFF), A_IN(8) + layer * 64, (bf16*)(WSP + WS_OMIX), gw, NGW, lane); }
        GRID_BAR();
        { LAUNDER(); pg8::Gemm g{(const bf16*)(WSP + WS_OMIX), (const bf16*)(WSP + WS_WOUT) + (size_t)layer * D * D, T, D, D, D}; pg8::StaticOrder S; S.init(T, D, GX(), BX());
          pg8::EpiResid<(layer & 1) == 0> E{(const bf16*)HD0, (bf16*)(WSP + WS_HN), D, (float*)(WSP + WS_STATA)};
          pg8::gemm_phase<pg8::EpiResid<(layer & 1) == 0>, pg8::StaticOrder, true, true>(LDSP + RING_OFF, g, S, E, wave_s); }
        GRID_BAR();
        if ((layer & 1) == 0) {
            { IDS(); LAUNDER(); const float* p = A_IN(1) + (size_t)layer * T * PLE; bf16* PB = (bf16*)(WSP + WS_PB);
          for (size_t i = (size_t)(vcu * NTHR + tid); i < (size_t)T * PLE / 8; i += (size_t)G * NTHR) { const f32x4 x0 = *(const f32x4*)(p + 8 * i), x1 = *(const f32x4*)(p + 8 * i + 4);
              v4u o; o.x = pk2(x0[0], x0[1]); o.y = pk2(x0[2], x0[3]); o.z = pk2(x1[0], x1[1]); o.w = pk2(x1[2], x1[3]); *(v4u*)(PB + 8 * i) = o; } }
            { LAUNDER(); const int j = layer >> 1; pg8::Gemm g{(const bf16*)(WSP + WS_HN), (const bf16*)(WSP + WS_WF13) + (size_t)j * 2 * DFF * D, T, 2 * DFF, D, D}; pg8::StaticOrder S; S.init(T, 2 * DFF, GX(), BX());
              pg8::build_row_scales(S, (const float*)(WSP + WS_STATA), (LAS float*)(LDSP + RTAB_OFF), wave_s * 64 + mk_lane());
              pg8::EpiSwiGLU<true> E{(bf16*)(WSP + WS_ACT), DFF, 1 << 20, (const LAS float*)(LDSP + RTAB_OFF)};
              pg8::gemm_phase<pg8::EpiSwiGLU<true>, pg8::StaticOrder, true, true>(LDSP + RING_OFF, g, S, E, wave_s); }
            GRID_BAR();
            { LAUNDER(); const int j = layer >> 1; pg8::Gemm g{(const bf16*)(WSP + WS_ACT), (const bf16*)(WSP + WS_WF2) + (size_t)j * D * DFF, T, D, DFF, DFF}; pg8::StaticOrder S; S.init(T, D, GX(), BX());
              pg8::EpiResid<true> E{(const bf16*)(WSP + WS_HN), HD1, D, (float*)(WSP + WS_STATB)};
              pg8::gemm_phase<pg8::EpiResid<true>, pg8::StaticOrder, true, true>(LDSP + RING_OFF, g, S, E, wave_s); }
        } else {
            { IDS(); LAUNDER(); LAS float* rl = (LAS float*)(LDSP + RING_OFF); const float* rw = A_IN(15) + (size_t)(layer >> 1) * D * NE;
              for (int i = tid; i < D * NE; i += NTHR) rl[i] = rw[i];
              __syncthreads();
              norm_phase(WSP + WS_HN, false, A_IN(11) + layer * D, HD1, nullptr, 0, nullptr, nullptr, nullptr, nullptr, nullptr, true, rl, (int*)(WSP + WS_ROUTE), (float*)(WSP + WS_ROUTE + 131072), gw, NGW, lane);
              __syncthreads(); }
            GRID_BAR();
            { IDS(); LAUNDER(); moe_slot_phase((const int*)(WSP + WS_ROUTE), (int*)(WSP + WS_ROUTE + 131072 + 262144), (unsigned*)(WSP + WS_ROUTE + ROWTOK_OFF), LDSP, gw, NGW, wave, lane, tid); }
            GRID_BAR();
            { LAUNDER(); const int j = layer >> 1; const LAS int* tab = (const LAS int*)(LDSP + TILEE_OFF); const int Mp = tab[300];
              pg8::Gemm g{(const bf16*)HD1, (const bf16*)(WSP + WS_WM13) + (size_t)j * NE * 2 * MFF * D, Mp, 2 * MFF, D, D};     pg8::GroupedOrderT<true> S; S.init(Mp, 2 * MFF, GX(), BX(), tab); S.rowtok = (const unsigned*)(WSP + WS_ROUTE + ROWTOK_OFF); S.gtab = LDSP + RTAB_OFF;
              pg8::EpiSwiGLU<false> E{(bf16*)(WSP + WS_MACT), MFF, 2 * MFF / 256, nullptr};
              pg8::gemm_phase<pg8::EpiSwiGLU<false>, pg8::GroupedOrderT<true>, true, true>(LDSP + RING_OFF, g, S, E, wave_s); }
            GRID_BAR();
            { LAUNDER(); const int j = layer >> 1; const LAS int* tab = (const LAS int*)(LDSP + TILEE_OFF);
              pg8::Gemm g{(const bf16*)(WSP + WS_MACT), (const bf16*)(WSP + WS_WM2) + (size_t)j * NE * D * MFF, 2 * T, D, MFF, MFF}; pg8::GroupedOrder S; S.init(2 * T, D, GX(), BX(), tab);
              pg8::EpiStore<false> E{(bf16*)(WSP + WS_ASORT), D, D / 256, nullptr, 0};
              pg8::gemm_phase<pg8::EpiStore<false>, pg8::GroupedOrder, true, true>(LDSP + RING_OFF, g, S, E, wave_s); }
            { LAUNDER(); const int j = layer >> 1; const LAS int* tab = (const LAS int*)(LDSP + TILEE_OFF); const int Mp = tab[300];
              pg8::Gemm g{(const bf16*)(WSP + WS_MACT), (const bf16*)(WSP + WS_WM2) + (size_t)j * NE * D * MFF, Mp, D, MFF, MFF / 4}; pg8::TailOrder S; S.init(Mp, 2 * T / 256, MFF / 4, GX(), BX(), tab);
              pg8::EpiStore<false> E{HD0 - (size_t)2 * T * D, D, D / 256, nullptr, (long)2048 * D};
              pg8::gemm_phase<pg8::EpiStore<false>, pg8::TailOrder, true, true>(LDSP + RING_OFF, g, S, E, wave_s); }
            GRID_BAR();
            { IDS(); LAUNDER(); norm_phase(WSP + WS_HN, false, A_IN(20) + layer * D, HD1, nullptr, 1, (const bf16*)(WSP + WS_ASORT),   (const bf16*)HD0, (const int*)(WSP + WS_ROUTE + 131072 + 262144), (const float*)(WSP + WS_ROUTE + 131072), (float*)(WSP + WS_STATB), false, (const LAS float*)LDSP, nullptr, nullptr, gw, NGW, lane); }
            { IDS(); LAUNDER(); const float* p = A_IN(1) + (size_t)layer * T * PLE; bf16* PB = (bf16*)(WSP + WS_PB);
          for (size_t i = (size_t)(vcu * NTHR + tid); i < (size_t)T * PLE / 8; i += (size_t)G * NTHR) { const f32x4 x0 = *(const f32x4*)(p + 8 * i), x1 = *(const f32x4*)(p + 8 * i + 4);
              v4u o; o.x = pk2(x0[0], x0[1]); o.y = pk2(x0[2], x0[3]); o.z = pk2(x1[0], x1[1]); o.w = pk2(x1[2], x1[3]); *(v4u*)(PB + 8 * i) = o; } }
        }
        GRID_BAR();
        { LAUNDER(); pg8::Gemm g{(const bf16*)(WSP + WS_PB), (const bf16*)(WSP + WS_WPROJ) + (size_t)layer * D * PLE, T, D, PLE, PLE}; pg8::StaticOrder S; S.init(T, D, GX(), BX());
          pg8::EpiPleP E{(bf16*)(WSP + WS_POUT), D};
          pg8::gemm_phase<pg8::EpiPleP, pg8::StaticOrder, true, true>(LDSP + RING_OFF, g, S, E, wave_s); }
        { LAUNDER(); pg8::Gemm g{(const bf16*)HD1, (const bf16*)(WSP + WS_WGATE) + (size_t)layer * D * D, T, D, D, D}; pg8::StaticOrder S; S.init(T, D, GX(), BX());
          pg8::build_row_scales(S, (const float*)(WSP + WS_STATB), (LAS float*)(LDSP + RTAB_OFF), wave_s * 64 + mk_lane());
          pg8::EpiPleG<(layer < DEPTH - 1)> E{(const bf16*)HD1, layer < DEPTH - 1 ? HD0 : (bf16*)(WSP + WS_HN), (const bf16*)(WSP + WS_POUT), D, (const LAS float*)(LDSP + RTAB_OFF), (float*)(WSP + WS_STATA)};
          pg8::gemm_phase<pg8::EpiPleG<(layer < DEPTH - 1)>, pg8::StaticOrder, true, true>(LDSP + RING_OFF, g, S, E, wave_s); }
        GRID_BAR();
}
__global__ void __launch_bounds__(NTHR, 2) mega_fwd(Args a_by_value) {
    extern __shared__ __attribute__((aligned(16))) unsigned char lds_raw[];
    const CAS Args* ap;
    const int wave_s = __builtin_amdgcn_readfirstlane((int)threadIdx.x >> 6);
    { IDS(); for (int u = tid; u < (LDS_BYTES - LDSCTL_OFF) / 4; u += NTHR) ((LAS unsigned*)(LDSP + LDSCTL_OFF))[u] = 0u;
      __syncthreads();
      LAUNDER(); (void)xcd_barrier_post((unsigned*)(WSP + WS_CTL) + CW_BAR, (volatile LAS unsigned*)(LDSP + MISC_OFF) + 8); }

    { IDS(); LAUNDER(); prologue_phase(ap, LDSP, gw, NGW, wave, lane); }
    { IDS(); LAUNDER(); norm_phase(A_IN(0), true, A_IN(2), HD0, nullptr, 1, nullptr, nullptr, nullptr, nullptr, (float*)(WSP + WS_STATA), false, (const LAS float*)LDSP, nullptr, nullptr, gw, NGW, lane); }
    GRID_BAR();

    layer_body<0>(wave_s); layer_body<1>(wave_s); layer_body<2>(wave_s); layer_body<3>(wave_s);
    { IDS(); LAUNDER(); float* H = HOUT;
      norm_phase(WSP + WS_HN, false, A_IN(22), nullptr, H, 2, nullptr, nullptr, nullptr, nullptr, nullptr, false, (const LAS float*)LDSP, nullptr, nullptr, gw, NGW, lane);
      if (bx == 0 && tid == 0) { if (__hip_atomic_load((gu32*)(WSP + WS_CTL) + CW_BAR + XB_TMO, RLX_AGENT) != 0u) { asm volatile("s_waitcnt vmcnt(0)" ::: "memory"); H[0] = __builtin_nanf(""); } } }
}

extern "C" void kernel_launch(void* const* d_in, const int* in_sizes, int n_in, void* d_out, int out_size, void* d_ws, size_t ws_size, hipStream_t stream) {
    static int grid = 0;
    if (grid == 0) {
        if (n_in != 23 || in_sizes[0] != T * D || out_size != T * D || ws_size < WS_END) { fprintf(stderr, "kernel_launch: unexpected shapes / workspace (n_in %d, in0 %d, out %d, ws %zu < %zu); nothing launched\n", n_in, n_in > 0 ? in_sizes[0] : -1, out_size, ws_size, (size_t)WS_END); grid = -1; return; }
        int dev = 0, cus = 0, per_cu = 0;
        if (hipGetDevice(&dev) != hipSuccess || hipDeviceGetAttribute(&cus, hipDeviceAttributeMultiprocessorCount, dev) != hipSuccess) { grid = -1; return; }
        if (hipFuncSetAttribute((const void*)mega_fwd, hipFuncAttributeMaxDynamicSharedMemorySize, LDS_BYTES) != hipSuccess) { fprintf(stderr, "kernel_launch: hipFuncSetAttribute failed\n"); grid = -1; return; }
        if (hipOccupancyMaxActiveBlocksPerMultiprocessor(&per_cu, (const void*)mega_fwd, NTHR, LDS_BYTES) != hipSuccess || per_cu < 1) { fprintf(stderr, "kernel_launch: occupancy query reports %d blocks per CU; nothing launched\n", per_cu); (void)hipGetLastError(); grid = -1; return; }
        (void)hipGetLastError();
        grid = cus;
    }
    if (grid < 0) return;
    if (hipMemsetAsync((char*)d_ws + WS_CTL, 0, CTL_ZERO_BYTES, stream) != hipSuccess) return;
    Args a{};
    for (int i = 0; i < 23; ++i) a.in[i] = (const float*)d_in[i];
    a.out = (float*)d_out; a.ws = (unsigned char*)d_ws;
    hipLaunchKernelGGL(mega_fwd, dim3(grid), dim3(NTHR), LDS_BYTES, stream, a);
}
```
